# Optimizing an MI355X kernel written in HIP

```python
import jax
import jax.numpy as jnp
from jax import lax
import numpy as np

D_MODEL = 1024
BATCH = 2
SEQ = 16384
DEPTH = 2

D_MIX = D_MODEL
POOL_WIDTH = D_MIX // 4
POOL_WINDOWS = (2, 4, 8, 16)
POOL_GROUP_DIM = POOL_WIDTH // len(POOL_WINDOWS)
NSA_WIDTH = D_MIX - POOL_WIDTH
N_Q_HEADS = 8
HEAD_DIM = NSA_WIDTH // N_Q_HEADS
N_KV_GROUPS = 2
HEADS_PER_GROUP = N_Q_HEADS // N_KV_GROUPS
KV_WIDTH = N_KV_GROUPS * HEAD_DIM
N_BRANCHES = 3
CMP_STRIDE = 16
CMP_BLOCK = 2 * CMP_STRIDE
SLC_BLOCK = 64
N_SELECT = 16
WINDOW = 512
Q_BLOCK = 128
D_FF = 2816
D_IN = POOL_WIDTH + NSA_WIDTH + 6 * KV_WIDTH + N_BRANCHES * N_Q_HEADS
ALPHA = (2.0 * DEPTH) ** 0.25
BETA = (8.0 * DEPTH) ** -0.25
LN_EPS = 1e-5
NEG_BIG = -1e30
SEL_BIG = 1e30

kernel_name = 'hymba_pool_nsa_macaron_deepnorm'


def layer_norm(x, g, b):
    xf = x.astype(jnp.float32)
    mu = jnp.mean(xf, axis=-1, keepdims=True)
    var = jnp.mean(jnp.square(xf - mu), axis=-1, keepdims=True)
    y = (xf - mu) * lax.rsqrt(var + LN_EPS) * g.astype(jnp.float32) + b.astype(jnp.float32)
    return y.astype(x.dtype)


def swiglu(x, w_gate, w_up, w_down):
    return (jax.nn.silu(x @ w_gate) * (x @ w_up)) @ w_down


def masked_softmax(s, mask):
    s = jnp.where(mask, s, NEG_BIG)
    m = jnp.max(s, axis=-1, keepdims=True)
    e = jnp.exp(s - m) * mask
    return e / jnp.maximum(jnp.sum(e, axis=-1, keepdims=True), 1e-30)


def pool_mixer(u, pool_w, pool_scale):
    B, S, _ = u.shape
    uf = u.astype(jnp.float32)
    csum = jnp.pad(jnp.cumsum(uf, axis=1), ((0, 0), (1, 0), (0, 0)))
    t = jnp.arange(S)
    groups = []
    for g, w in enumerate(POOL_WINDOWS):
        sl = slice(g * POOL_GROUP_DIM, (g + 1) * POOL_GROUP_DIM)
        cg = csum[..., sl]
        lo = jnp.maximum(t + 1 - w, 0)
        win_sum = cg[:, 1:] - cg[:, lo]
        cnt = jnp.minimum(t + 1, w).astype(jnp.float32)[None, :, None]
        groups.append(win_sum / cnt - uf[..., sl])
    pooled = jnp.stack(groups, axis=2).astype(u.dtype)
    mixed = jnp.einsum('bsgc,gcd->bsgd', pooled, pool_w)
    return mixed.reshape(B, S, POOL_WIDTH) * pool_scale


def compress(kv, pos, w1, w2):
    B, G, S, dh = kv.shape
    chunks = kv.reshape(B, G, S // CMP_STRIDE, CMP_STRIDE, dh)
    blocks = jnp.concatenate([chunks[:, :, :-1], chunks[:, :, 1:]], axis=3)
    flat = (blocks + pos).reshape(B, G, S // CMP_STRIDE - 1, CMP_BLOCK * dh)
    return jax.nn.gelu(flat @ w1) @ w2


def nsa_mixer(q, kc, vc, k_slc, v_slc, k_win, v_win, gates):
    B, S = q.shape[0], q.shape[1]
    G = N_KV_GROUPS
    NQB = S // Q_BLOCK
    NS = S // SLC_BLOCK
    NC = S // CMP_STRIDE - 1
    n_sel = min(N_SELECT, NS)
    scale = HEAD_DIM ** -0.5
    qb = (q * scale).reshape(B, NQB, Q_BLOCK, G, HEADS_PER_GROUP, HEAD_DIM).transpose(1, 0, 3, 4, 2, 5)
    gb = gates.reshape(B, NQB, Q_BLOCK, G, HEADS_PER_GROUP, N_BRANCHES).transpose(1, 0, 3, 4, 2, 5)
    ks_blocks = k_slc.reshape(B, G, NS, SLC_BLOCK, HEAD_DIM)
    vs_blocks = v_slc.reshape(B, G, NS, SLC_BLOCK, HEAD_DIM)
    kw_pad = jnp.pad(k_win, ((0, 0), (0, 0), (WINDOW, 0), (0, 0)))
    vw_pad = jnp.pad(v_win, ((0, 0), (0, 0), (WINDOW, 0), (0, 0)))
    cmp_end = jnp.arange(NC) * CMP_STRIDE + CMP_BLOCK - 1
    blk = jnp.arange(NS)
    bi = jnp.arange(B)[:, None, None, None]
    gi = jnp.arange(G)[None, :, None, None]
    slc_w = jnp.array([0.5, 1.0, 1.0, 1.0], jnp.float32)

    def one_block(args):
        c, q_c, g_c = args
        t = c * Q_BLOCK + jnp.arange(Q_BLOCK)
        s = jnp.einsum('bghtd,bgnd->bghtn', q_c, kc).astype(jnp.float32)
        p_cmp = masked_softmax(s, cmp_end[None, :] <= t[:, None])
        o_cmp = jnp.einsum('bghtn,bgnd->bghtd', p_cmp.astype(vc.dtype), vc)
        imp = jnp.pad(p_cmp.sum(axis=2), ((0, 0), (0, 0), (0, 0), (1, 1)))
        imp_slc = imp[..., :4 * NS].reshape(B, G, Q_BLOCK, NS, 4) @ slc_w + 0.5 * imp[..., 4::4]
        jt = (t // SLC_BLOCK)[:, None]
        forced = (blk == 0) | (blk == jt) | (blk == jt - 1)
        score = jnp.where(blk <= jt, jnp.where(forced, SEL_BIG, imp_slc), NEG_BIG)
        top_s, idx = lax.top_k(score, n_sel)
        sel_ok = top_s > 0.5 * NEG_BIG
        ks = ks_blocks[bi, gi, idx].reshape(B, G, Q_BLOCK, n_sel * SLC_BLOCK, HEAD_DIM)
        vs = vs_blocks[bi, gi, idx].reshape(B, G, Q_BLOCK, n_sel * SLC_BLOCK, HEAD_DIM)
        pos = (idx[..., None] * SLC_BLOCK + jnp.arange(SLC_BLOCK)).reshape(B, G, Q_BLOCK, n_sel * SLC_BLOCK)
        m_slc = (pos <= t[:, None]) & jnp.repeat(sel_ok, SLC_BLOCK, axis=-1)
        s = jnp.einsum('bghtd,bgtkd->bghtk', q_c, ks).astype(jnp.float32)
        p = masked_softmax(s, m_slc[:, :, None])
        o_slc = jnp.einsum('bghtk,bgtkd->bghtd', p.astype(vs.dtype), vs)
        start = c * Q_BLOCK
        kw = lax.dynamic_slice_in_dim(kw_pad, start, WINDOW + Q_BLOCK, axis=2)
        vw = lax.dynamic_slice_in_dim(vw_pad, start, WINDOW + Q_BLOCK, axis=2)
        s_pos = start - WINDOW + jnp.arange(WINDOW + Q_BLOCK)
        diff = t[:, None] - s_pos[None, :]
        m_win = (s_pos[None, :] >= 0) & (diff >= 0) & (diff < WINDOW)
        s = jnp.einsum('bghtd,bgkd->bghtk', q_c, kw).astype(jnp.float32)
        p = masked_softmax(s, m_win)
        o_win = jnp.einsum('bghtk,bgkd->bghtd', p.astype(vw.dtype), vw)
        o = g_c[..., 0:1] * o_cmp + g_c[..., 1:2] * o_slc + g_c[..., 2:3] * o_win
        return o.transpose(0, 3, 1, 2, 4).reshape(B, Q_BLOCK, NSA_WIDTH)

    out = lax.map(one_block, (jnp.arange(NQB), qb, gb))
    return out.transpose(1, 0, 2, 3).reshape(B, S, NSA_WIDTH)


def hybrid_mixer(x, w_in, b_gate, pool_w, pool_scale, cmp_pos_k, cmp_k_w1, cmp_k_w2,
                 cmp_pos_v, cmp_v_w1, cmp_v_w2, w_out):
    B, S, _ = x.shape
    proj = x @ w_in
    cuts = tuple(int(v) for v in np.cumsum([POOL_WIDTH, NSA_WIDTH] + [KV_WIDTH] * 6))
    u, q, kc, vc, ks, vs, kw, vw, g = jnp.split(proj, cuts, axis=-1)
    y_pool = pool_mixer(u, pool_w, pool_scale)

    def heads(a):
        return a.reshape(B, S, N_KV_GROUPS, HEAD_DIM).transpose(0, 2, 1, 3)

    k_cmp = compress(heads(kc), cmp_pos_k, cmp_k_w1, cmp_k_w2)
    v_cmp = compress(heads(vc), cmp_pos_v, cmp_v_w1, cmp_v_w2)
    gates = jax.nn.sigmoid((g + b_gate).astype(jnp.float32)).astype(x.dtype)
    gates = gates.reshape(B, S, N_Q_HEADS, N_BRANCHES)
    y_nsa = nsa_mixer(q.reshape(B, S, N_Q_HEADS, HEAD_DIM), k_cmp, v_cmp,
                      heads(ks), heads(vs), heads(kw), heads(vw), gates)
    return jnp.concatenate([y_pool, y_nsa], axis=-1) @ w_out


def setup_inputs(seed: int = 0) -> dict:
    key = jax.random.key(seed)
    k = jax.random.split(key, 24)
    L = DEPTH

    def nrm(kk, shape, scale):
        return jax.random.normal(kk, shape, jnp.float32) * scale

    return {
        'x': nrm(k[0], (BATCH, SEQ, D_MODEL), 1.0),
        'ln1_g': 1.0 + nrm(k[1], (L, D_MODEL), 0.02),
        'ln1_b': nrm(k[2], (L, D_MODEL), 0.02),
        'ffn1_w_gate': nrm(k[3], (L, D_MODEL, D_FF), D_MODEL ** -0.5),
        'ffn1_w_up': nrm(k[4], (L, D_MODEL, D_FF), D_MODEL ** -0.5),
        'ffn1_w_down': nrm(k[5], (L, D_FF, D_MODEL), BETA * D_FF ** -0.5),
        'w_in': nrm(k[6], (L, D_MODEL, D_IN), D_MODEL ** -0.5),
        'b_gate': nrm(k[7], (L, N_BRANCHES * N_Q_HEADS), 0.5),
        'pool_w': nrm(k[8], (L, len(POOL_WINDOWS), POOL_GROUP_DIM, POOL_GROUP_DIM), POOL_GROUP_DIM ** -0.5),
        'pool_scale': 1.0 + nrm(k[9], (L, POOL_WIDTH), 0.02),
        'cmp_pos_k': nrm(k[10], (L, CMP_BLOCK, HEAD_DIM), 0.02),
        'cmp_k_w1': nrm(k[11], (L, CMP_BLOCK * HEAD_DIM, HEAD_DIM), (CMP_BLOCK * HEAD_DIM) ** -0.5),
        'cmp_k_w2': nrm(k[12], (L, HEAD_DIM, HEAD_DIM), HEAD_DIM ** -0.5),
        'cmp_pos_v': nrm(k[13], (L, CMP_BLOCK, HEAD_DIM), 0.02),
        'cmp_v_w1': nrm(k[14], (L, CMP_BLOCK * HEAD_DIM, HEAD_DIM), (CMP_BLOCK * HEAD_DIM) ** -0.5),
        'cmp_v_w2': nrm(k[15], (L, HEAD_DIM, HEAD_DIM), HEAD_DIM ** -0.5),
        'w_out': nrm(k[16], (L, D_MIX, D_MODEL), BETA * D_MIX ** -0.5),
        'ln2_g': 1.0 + nrm(k[17], (L, D_MODEL), 0.02),
        'ln2_b': nrm(k[18], (L, D_MODEL), 0.02),
        'ffn2_w_gate': nrm(k[19], (L, D_MODEL, D_FF), D_MODEL ** -0.5),
        'ffn2_w_up': nrm(k[20], (L, D_MODEL, D_FF), D_MODEL ** -0.5),
        'ffn2_w_down': nrm(k[21], (L, D_FF, D_MODEL), BETA * D_FF ** -0.5),
        'ln3_g': 1.0 + nrm(k[22], (L, D_MODEL), 0.02),
        'ln3_b': nrm(k[23], (L, D_MODEL), 0.02),
    }


def reference(x, ln1_g, ln1_b, ffn1_w_gate, ffn1_w_up, ffn1_w_down, w_in, b_gate,
              pool_w, pool_scale, cmp_pos_k, cmp_k_w1, cmp_k_w2, cmp_pos_v, cmp_v_w1,
              cmp_v_w2, w_out, ln2_g, ln2_b, ffn2_w_gate, ffn2_w_up, ffn2_w_down,
              ln3_g, ln3_b):
    for l in range(DEPTH):
        x = layer_norm(ALPHA * x + 0.5 * swiglu(x, ffn1_w_gate[l], ffn1_w_up[l], ffn1_w_down[l]),
                       ln1_g[l], ln1_b[l])
        y = hybrid_mixer(x, w_in[l], b_gate[l], pool_w[l], pool_scale[l], cmp_pos_k[l],
                         cmp_k_w1[l], cmp_k_w2[l], cmp_pos_v[l], cmp_v_w1[l], cmp_v_w2[l], w_out[l])
        x = layer_norm(ALPHA * x + y, ln2_g[l], ln2_b[l])
        x = layer_norm(ALPHA * x + 0.5 * swiglu(x, ffn2_w_gate[l], ffn2_w_up[l], ffn2_w_down[l]),
                       ln3_g[l], ln3_b[l])
    return x
```

```cpp
#include <hip/hip_runtime.h>
#include <hip/hip_cooperative_groups.h>
#include <cstdio>
namespace cg = cooperative_groups;

#define LAS __attribute__((address_space(3)))
typedef unsigned short bf16_t;
typedef short bf16x8 __attribute__((ext_vector_type(8)));
typedef float f32x4 __attribute__((ext_vector_type(4)));
typedef unsigned u32x4 __attribute__((ext_vector_type(4)));
typedef unsigned u32x2 __attribute__((ext_vector_type(2)));

constexpr int SEQ = 16384, MTOK = 32768, DM = 1024, DFF = 2816, NPROJ = 2048, NVT = 512;
constexpr int C_Q = 256, C_KC = 1024, C_VC = 1216, C_KS = 1408, C_KW = 1600, C_G = 1792;
constexpr float ALPHA = 1.41421356237309515f;
constexpr int LDS_BYTES = 160 * 1024;

constexpr size_t SZ_WGU = (size_t)5632 * 1024 * 2, SZ_WDN = (size_t)1024 * 2816 * 2, SZ_WIN = (size_t)NPROJ * 1024 * 2, SZ_WVT = (size_t)NVT * 1024 * 2,
                 SZ_WOUT = (size_t)1024 * 1024 * 2, SZ_WC1 = (size_t)96 * 3072 * 2, SZ_WC2 = (size_t)96 * 96 * 2, SZ_POSW = 512;
constexpr size_t WS_WGU = 0, WS_WDN = WS_WGU + 4 * SZ_WGU, WS_WIN = WS_WDN + 4 * SZ_WDN, WS_WVT = WS_WIN + 2 * SZ_WIN, WS_WOUT = WS_WVT + 2 * SZ_WVT,
                 WS_WC1 = WS_WOUT + 2 * SZ_WOUT, WS_WC2 = WS_WC1 + 4 * SZ_WC1, WS_POSW = WS_WC2 + 4 * SZ_WC2, WS_XB = WS_POSW + 4 * SZ_POSW,
                 WS_KCMP = WS_XB + (size_t)MTOK * DM * 2, WS_VCMPT = WS_KCMP + (size_t)4 * 1024 * 96 * 2, WS_BIG = WS_VCMPT + (size_t)4 * 96 * 1024 * 2,
                 WS_H = WS_BIG, WS_PROJ = WS_BIG, WS_VTB = WS_PROJ + (size_t)MTOK * NPROJ * 2, WS_CONCAT = WS_VTB + (size_t)NVT * MTOK * 2,
                 WS_END = WS_CONCAT + (size_t)MTOK * DM * 2;
constexpr size_t WS_XCH = WS_END, SZ_XCH = (size_t)64 * 256 * 4 * 8, WS_CNT = WS_XCH + 12 * SZ_XCH, WS_BAR = WS_CNT + (size_t)12 * 64 * 256, WS_POSP = WS_BAR + 16384, WS_END2 = WS_POSP + (size_t)4 * 32 * 96 * 4;
static_assert(WS_END >= WS_H + (size_t)MTOK * DFF * 2, "union");
static_assert(WS_END2 + 256 <= (size_t)512 * 1024 * 1024, "ws");
static_assert(WS_XB % 256 == 0 && WS_BIG % 256 == 0, "align");

__device__ __forceinline__ int tid_fresh() { int t = threadIdx.x; asm volatile("" : "+v"(t)); return t; }
typedef __bf16 bf16v2_t __attribute__((ext_vector_type(2)));
typedef float f32v2_t __attribute__((ext_vector_type(2)));
__device__ __forceinline__ unsigned cvt_pk_bf16(float lo, float hi) { const f32v2_t v = {lo, hi}; return __builtin_bit_cast(unsigned, __builtin_convertvector(v, bf16v2_t)); }
typedef _Float16 f16v2_t __attribute__((ext_vector_type(2)));
typedef _Float16 f16x8 __attribute__((ext_vector_type(8)));
__device__ __forceinline__ unsigned cvt_pk_f16(float lo, float hi) { const f32v2_t v = {lo, hi}; return __builtin_bit_cast(unsigned, __builtin_convertvector(v, f16v2_t)); }
__device__ __forceinline__ unsigned cvt_pk_f16_b(float lo, float hi) { const unsigned b = cvt_pk_bf16(lo, hi); return cvt_pk_f16(__uint_as_float(b << 16), __uint_as_float(b & 0xffff0000u)); }
__device__ __forceinline__ f32v2_t unpk_f16(unsigned u) { return __builtin_convertvector(__builtin_bit_cast(f16v2_t, u), f32v2_t); }
__device__ __forceinline__ bf16_t f2h(float f) { return (bf16_t)(cvt_pk_f16(f, 0.f) & 0xffffu); }
__device__ __forceinline__ bf16_t f2bf(float f) { return (bf16_t)(cvt_pk_bf16(f, 0.f) & 0xffffu); }
__device__ __forceinline__ float bf2f(bf16_t b) { return __uint_as_float(((unsigned)b) << 16); }

__device__ __forceinline__ float xr16_max(float x) { const auto r = __builtin_amdgcn_permlane16_swap(__float_as_uint(x), __float_as_uint(x), false, false); return fmaxf(__uint_as_float(r[0]), __uint_as_float(r[1])); }
__device__ __forceinline__ float xr32_max(float x) { const auto r = __builtin_amdgcn_permlane32_swap(__float_as_uint(x), __float_as_uint(x), false, false); return fmaxf(__uint_as_float(r[0]), __uint_as_float(r[1])); }
__device__ __forceinline__ float xr16_sum(float x) { const auto r = __builtin_amdgcn_permlane16_swap(__float_as_uint(x), __float_as_uint(x), false, false); return __uint_as_float(r[0]) + __uint_as_float(r[1]); }
__device__ __forceinline__ float xr32_sum(float x) { const auto r = __builtin_amdgcn_permlane32_swap(__float_as_uint(x), __float_as_uint(x), false, false); return __uint_as_float(r[0]) + __uint_as_float(r[1]); }
template <int CTRL> __device__ __forceinline__ unsigned dpp_u(unsigned x) { return (unsigned)__builtin_amdgcn_update_dpp((int)x, (int)x, CTRL, 0xF, 0xF, false); }
template <int CTRL> __device__ __forceinline__ float dpp_f(float x) { return __uint_as_float(dpp_u<CTRL>(__float_as_uint(x))); }
constexpr int DPP_XOR1 = 0xB1, DPP_XOR2 = 0x4E, DPP_ROR4 = 0x124, DPP_ROR8 = 0x128;
__device__ __forceinline__ unsigned long long u64max(unsigned long long a, unsigned long long b) { return a > b ? a : b; }
__device__ __forceinline__ unsigned long long wave_max_u64(unsigned long long v) {
    unsigned lo = (unsigned)v, hi = (unsigned)(v >> 32);
    { const auto a = __builtin_amdgcn_permlane32_swap(lo, lo, false, false); const auto b = __builtin_amdgcn_permlane32_swap(hi, hi, false, false);
      v = u64max(((unsigned long long)b[0] << 32) | a[0], ((unsigned long long)b[1] << 32) | a[1]); lo = (unsigned)v; hi = (unsigned)(v >> 32); }
    { const auto a = __builtin_amdgcn_permlane16_swap(lo, lo, false, false); const auto b = __builtin_amdgcn_permlane16_swap(hi, hi, false, false);
      v = u64max(((unsigned long long)b[0] << 32) | a[0], ((unsigned long long)b[1] << 32) | a[1]); lo = (unsigned)v; hi = (unsigned)(v >> 32); }
    v = u64max(v, ((unsigned long long)dpp_u<DPP_XOR1>(hi) << 32) | dpp_u<DPP_XOR1>(lo)); lo = (unsigned)v; hi = (unsigned)(v >> 32);
    v = u64max(v, ((unsigned long long)dpp_u<DPP_XOR2>(hi) << 32) | dpp_u<DPP_XOR2>(lo)); lo = (unsigned)v; hi = (unsigned)(v >> 32);
    v = u64max(v, ((unsigned long long)dpp_u<DPP_ROR4>(hi) << 32) | dpp_u<DPP_ROR4>(lo)); lo = (unsigned)v; hi = (unsigned)(v >> 32);
    v = u64max(v, ((unsigned long long)dpp_u<DPP_ROR8>(hi) << 32) | dpp_u<DPP_ROR8>(lo));
    return v;
}

namespace pg8 {
constexpr int BM = 256, BK = 64, HALF = 128, HTB = HALF * BK * 2, STAGE_BYTES = 8 * HTB, NXCD = 8, WGM = 8;
__host__ __device__ __forceinline__ int lds_byte(int r, int c) { const int st = (r >> 4) * 2 + (c >> 5), rr = r & 15, cc = c & 31, ob = rr * 64 + cc * 2; return st * 1024 + (ob ^ (((ob >> 9) & 1) << 5)); }
__host__ __device__ __forceinline__ void stage_rc(int b, int& R, int& C) { const int st = b / 1024, sb = b % 1024, swz = sb ^ (((sb >> 9) & 1) << 5); R = (st >> 1) * 16 + swz / 64; C = (st & 1) * 32 + (swz % 64) / 2; }
__host__ __device__ __forceinline__ int perm32(int rho) { const int n = rho >> 4, i = rho & 15; return 8 * (i >> 2) + 4 * n + (i & 3); }
struct Unit { int pm, pn; };
struct Gemm { const bf16_t* A; const bf16_t* Bt; int M, N, K; };
struct StaticOrder {
    int nM, nN, nwg, G, c;
    __host__ __device__ void init(int M, int N, int G_, int c_) { nM = M / BM; nN = N / BM; nwg = nM * nN; G = G_; c = c_; }
    __host__ __device__ bool next(int i, Unit& u) const {
        const long L = (long)i * G + c; if (L >= nwg) return false;
        int wgid = (int)L; { const int q = nwg / NXCD, r = nwg % NXCD, xcd = wgid % NXCD, off = wgid / NXCD; wgid = (xcd < r ? xcd * (q + 1) : r * (q + 1) + (xcd - r) * q) + off; }
        const int nig = WGM * nN, gid = wgid / nig, fm = gid * WGM, gsz = (nM - fm) < WGM ? (nM - fm) : WGM;
        u.pm = fm + ((wgid % nig) % gsz); u.pn = (wgid % nig) / gsz; return true;
    }
    __device__ __forceinline__ void a_ready(const Unit&) const {}
    __device__ __forceinline__ void done(const Unit&) const {}
};

struct EpiBf16 {
    static constexpr bool PERM = true, AFTER_DRAIN = false;
    bf16_t* O; int ldc;
    __device__ __forceinline__ void operator()(const f32x4 (&acc)[2][2][4][2], const Unit& u, int wr, int wc, int fr, int fq) const {
        const int row0 = u.pm * BM + wr * 64 + fr, col0 = u.pn * BM + wc * 32 + 8 * fq;
#pragma unroll
        for (int ai = 0; ai < 2; ++ai)
#pragma unroll
            for (int m = 0; m < 4; ++m) { bf16_t* rowp = O + (size_t)(row0 + ai * HALF + m * 16) * ldc + col0;
#pragma unroll
                for (int bj = 0; bj < 2; ++bj) { const f32x4 v0 = acc[ai][bj][m][0], v1 = acc[ai][bj][m][1];
                    u32x4 w; w.x = cvt_pk_bf16(v0[0], v0[1]); w.y = cvt_pk_bf16(v0[2], v0[3]); w.z = cvt_pk_bf16(v1[0], v1[1]); w.w = cvt_pk_bf16(v1[2], v1[3]);
                    *(u32x4*)(rowp + bj * HALF) = w; } }
    }
};
struct EpiSwiglu {
    static constexpr bool PERM = true, AFTER_DRAIN = false;
    bf16_t* H; int ldh;
    __device__ __forceinline__ void operator()(const f32x4 (&acc)[2][2][4][2], const Unit& u, int wr, int wc, int fr, int fq) const {
        const int row0 = u.pm * BM + wr * 64 + fr, col0 = u.pn * HALF + wc * 32 + 8 * fq;
#pragma unroll
        for (int ai = 0; ai < 2; ++ai)
#pragma unroll
            for (int m = 0; m < 4; ++m) { bf16_t* rowp = H + (size_t)(row0 + ai * HALF + m * 16) * ldh + col0;
                float h[8];
#pragma unroll
                for (int n = 0; n < 2; ++n)
#pragma unroll
                    for (int j = 0; j < 4; ++j) { const float g = acc[ai][0][m][n][j], up = acc[ai][1][m][n][j]; h[n * 4 + j] = g * up * __builtin_amdgcn_rcpf(1.0f + __builtin_amdgcn_exp2f(-1.4426950408889634f * g)); }
                u32x4 w; w.x = cvt_pk_f16_b(h[0], h[1]); w.y = cvt_pk_f16_b(h[2], h[3]); w.z = cvt_pk_f16_b(h[4], h[5]); w.w = cvt_pk_f16_b(h[6], h[7]);
                *(u32x4*)rowp = w; }
    }
};
struct PanelStats {
    unsigned* xbuf;
    unsigned* cnt;
    float eps;
    __device__ __forceinline__ void run(const f32x4 (&v)[2][2][4][2], const Unit& u, int wr, int wc, int fr, int fq, LAS unsigned char* lds, int wid, int lane) const {
        typedef float f32x2v __attribute__((ext_vector_type(2)));
        LAS f32x2v* P = (LAS f32x2v*)lds;
        LAS f32x2v* S = (LAS f32x2v*)(lds + 8192);
#pragma unroll
        for (int ai = 0; ai < 2; ++ai)
#pragma unroll
            for (int m = 0; m < 4; ++m) {
                float s = 0.f;
#pragma unroll
                for (int bj = 0; bj < 2; ++bj)
#pragma unroll
                    for (int n = 0; n < 2; ++n) { const f32x4 x = v[ai][bj][m][n]; s += (x[0] + x[1]) + (x[2] + x[3]); }
                s = xr32_sum(xr16_sum(s));
                const float mw = s * (1.0f / 64.0f); float q = 0.f;
#pragma unroll
                for (int bj = 0; bj < 2; ++bj)
#pragma unroll
                    for (int n = 0; n < 2; ++n) { const f32x4 d = v[ai][bj][m][n] - mw; q += (d[0] * d[0] + d[1] * d[1]) + (d[2] * d[2] + d[3] * d[3]); }
                q = xr32_sum(xr16_sum(q));
                if (fq == 0) P[(ai * HALF + wr * 64 + m * 16 + fr) * 4 + wc] = (f32x2v){mw, q};
            }
        asm volatile("s_waitcnt lgkmcnt(0)" ::: "memory"); __builtin_amdgcn_s_barrier(); asm volatile("" ::: "memory");
        const int row = wid * 32 + (lane & 31);
        if (lane < 32) {
            const f32x2v a = P[row * 4 + 0], b = P[row * 4 + 1], c = P[row * 4 + 2], d = P[row * 4 + 3];
            const float mt = (a.x + b.x + c.x + d.x) * 0.25f;
            const float da = a.x - mt, db = b.x - mt, dc = c.x - mt, dd = d.x - mt;
            const float m2 = (a.y + b.y) + (c.y + d.y) + 64.0f * ((da * da + db * db) + (dc * dc + dd * dd));
            unsigned long long* slot = (unsigned long long*)xbuf + ((size_t)(u.pm * BM + row) * 4 + u.pn);
            __hip_atomic_store(slot, ((unsigned long long)__float_as_uint(m2) << 32) | __float_as_uint(mt), __ATOMIC_RELAXED, __HIP_MEMORY_SCOPE_AGENT);
        }
        asm volatile("s_waitcnt vmcnt(0)" ::: "memory");
        if (lane == 0) __hip_atomic_fetch_add(cnt + 64 * u.pm, 1u, __ATOMIC_RELAXED, __HIP_MEMORY_SCOPE_AGENT);
        if (wid == 0) {
            for (unsigned it = 0; it < 200000000u; ++it) {
                if ((unsigned)__builtin_amdgcn_readfirstlane(__hip_atomic_load(cnt + 64 * u.pm, __ATOMIC_RELAXED, __HIP_MEMORY_SCOPE_AGENT)) >= 32u) break;
                __builtin_amdgcn_s_sleep(2);
            }
            __builtin_amdgcn_fence(__ATOMIC_ACQUIRE, "agent");
        }
        asm volatile("s_waitcnt vmcnt(0) lgkmcnt(0)" ::: "memory"); __builtin_amdgcn_s_barrier(); asm volatile("" ::: "memory");
        if (lane < 32) {
            const unsigned long long* slot = (const unsigned long long*)xbuf + (size_t)(u.pm * BM + row) * 4; float mt[4], m2[4]; float ms = 0.f;
#pragma unroll
            for (int t = 0; t < 4; ++t) { const unsigned long long w = __hip_atomic_load(slot + t, __ATOMIC_RELAXED, __HIP_MEMORY_SCOPE_AGENT); mt[t] = __uint_as_float((unsigned)w); m2[t] = __uint_as_float((unsigned)(w >> 32)); ms += mt[t]; }
            const float mean = ms * 0.25f; float q = 0.f;
#pragma unroll
            for (int t = 0; t < 4; ++t) { const float dm = mt[t] - mean; q += m2[t] + 256.0f * dm * dm; }
            S[row] = (f32x2v){mean, 1.0f / sqrtf(q * (1.0f / 1024.0f) + eps)};
        }
        asm volatile("s_waitcnt lgkmcnt(0)" ::: "memory"); __builtin_amdgcn_s_barrier(); asm volatile("" ::: "memory");
    }
};
struct EpiLnAff {
    static constexpr bool PERM = false, AFTER_DRAIN = true;
    const bf16_t* base; float* out  ; bf16_t* xb; const float* gam; const float* bet; float alpha, beta; PanelStats st;
    __device__ __forceinline__ void operator()(const f32x4 (&)[2][2][4][2], const Unit&, int, int, int, int) const {}
    __device__ __forceinline__ void fused(f32x4 (&acc)[2][2][4][2], const Unit& u, int wr, int wc, int fr, int fq, LAS unsigned char* lds, int wid, int lane) const {
        typedef float f32x2v __attribute__((ext_vector_type(2)));
        const LAS f32x2v* S = (const LAS f32x2v*)(lds + 8192);
        const int col0 = u.pn * BM + wc * 32 + 4 * fq;
        { const int t = wid * 64 + lane;
#pragma unroll
          for (int hf = 0; hf < 2; ++hf) { u32x4 v[8];
#pragma unroll
            for (int i = 0; i < 8; ++i) { const int id = t + 512 * (8 * hf + i), row = id >> 5, ch = id & 31; v[i] = *(const u32x4*)(base + (size_t)(u.pm * BM + row) * 1024 + u.pn * BM + ch * 8); }
#pragma unroll
            for (int i = 0; i < 8; ++i) { const int id = t + 512 * (8 * hf + i), row = id >> 5, ch = id & 31; *(LAS u32x4*)(lds + 16384 + row * 528 + ch * 16) = v[i]; }
            asm volatile("" ::: "memory"); } }
        asm volatile("s_waitcnt lgkmcnt(0)" ::: "memory"); __builtin_amdgcn_s_barrier(); asm volatile("" ::: "memory");
#pragma unroll
        for (int ai = 0; ai < 2; ++ai)
#pragma unroll
            for (int m = 0; m < 4; ++m) { const int rr = ai * HALF + wr * 64 + m * 16 + fr;
#pragma unroll
                for (int bj = 0; bj < 2; ++bj)
#pragma unroll
                    for (int n = 0; n < 2; ++n) { const u32x2 bw = *(const LAS u32x2*)(lds + 16384 + rr * 528 + (wc * 32 + 4 * fq + bj * HALF + n * 16) * 2);
                        const f32v2_t b01 = unpk_f16(bw.x), b23 = unpk_f16(bw.y); const f32x4 bs = {b01[0], b01[1], b23[0], b23[1]};
                        acc[ai][bj][m][n] = bs * alpha + acc[ai][bj][m][n] * beta; }
                asm volatile("" : "+v"(acc[ai][0][m][0]), "+v"(acc[ai][0][m][1]), "+v"(acc[ai][1][m][0]), "+v"(acc[ai][1][m][1]));
                if (m & 1) asm volatile("" ::: "memory"); }
        st.run(acc, u, wr, wc, fr, fq, lds, wid, lane);
#pragma unroll
        for (int bj = 0; bj < 2; ++bj)
#pragma unroll
            for (int n = 0; n < 2; ++n) { const f32x4 gv = *(const f32x4*)(gam + col0 + bj * HALF + n * 16), bv = *(const f32x4*)(bet + col0 + bj * HALF + n * 16);
#pragma unroll
                for (int ai = 0; ai < 2; ++ai)
#pragma unroll
                    for (int m = 0; m < 4; ++m) { const int r = ai * HALF + wr * 64 + m * 16 + fr; const f32x2v sr = S[r]; const size_t off = (size_t)(u.pm * BM + r) * 1024 + col0;
                        const f32x4 y = (acc[ai][bj][m][n] - sr.x) * sr.y * gv + bv; if (out) *(f32x4*)(out + off + bj * HALF + n * 16) = y;
                        u32x2 w; w.x = cvt_pk_f16(y[0], y[1]); w.y = cvt_pk_f16(y[2], y[3]);
                        *(LAS u32x2*)(lds + 16384 + r * 528 + (wc * 32 + 4 * fq + bj * HALF + n * 16) * 2) = w; }
                asm volatile("" ::: "memory"); }
        asm volatile("s_waitcnt lgkmcnt(0)" ::: "memory"); __builtin_amdgcn_s_barrier(); asm volatile("" ::: "memory");
        { const int t = wid * 64 + lane;
#pragma unroll
          for (int i = 0; i < 16; ++i) { const int id = t + 512 * i, row = id >> 5, ch = id & 31;
              *(u32x4*)(xb + (size_t)(u.pm * BM + row) * 1024 + u.pn * BM + ch * 8) = *(const LAS u32x4*)(lds + 16384 + row * 528 + ch * 16); } }
        asm volatile("s_waitcnt lgkmcnt(0)" ::: "memory"); __builtin_amdgcn_s_barrier(); asm volatile("" ::: "memory");
    }
};

template <class Epi, class Sched, bool ALIGN_EPI = false>
__device__ __forceinline__ void gemm_phase(LAS unsigned char* lds, const Gemm g, const Sched& S, const Epi& E) {
    int tid_ = threadIdx.x; asm volatile("" : "+v"(tid_));
    const int tid = tid_, wid = __builtin_amdgcn_readfirstlane(tid >> 6), lane = tid & 63, wr = wid >> 2, wc = wid & 3, fr = lane & 15, fq = lane >> 4;
    const int K = g.K, nt = K / BK;
    unsigned voffA[2], voffB[2];
#pragma unroll
    for (int i = 0; i < 2; ++i) { int R, C; stage_rc(tid * 16 + i * 8192, R, C); const int Rb = Epi::PERM ? ((R & ~31) + perm32(R & 31)) : R;
        voffA[i] = (unsigned)(R * K + C) * 2u; voffB[i] = (unsigned)(Rb * K + C) * 2u; }
    const size_t kstep = (size_t)(BK * 2);
    const size_t hstep = (size_t)HALF * K * 2;
    const size_t tstep = 2 * hstep;
    const unsigned ldsw = (unsigned)wid * 1024u;
    const int aoff = lds_byte(wr * 64 + fr, fq * 8), boff = lds_byte(wc * 32 + fr, fq * 8);
#define PG8_SA(b, h) (((b) * 2 + (h)) * HTB)
#define PG8_SB(b, h) ((4 + (b) * 2 + (h)) * HTB)
#define PG8_STAGE(bufoff, gbase, voff) do { _Pragma("unroll") for (int _i = 0; _i < 2; ++_i) \
        __builtin_amdgcn_global_load_lds((const unsigned*)((const char*)(gbase) + (voff)[_i]), (LAS unsigned*)(lds + (bufoff) + ldsw + _i * 8192), 16, 0, 0); } while (0)
#define PG8_LDA(dst, b, h) do { _Pragma("unroll") for (int m = 0; m < 4; ++m) _Pragma("unroll") for (int k = 0; k < 2; ++k) dst[m][k] = *(const LAS bf16x8*)(lds + PG8_SA(b, h) + aoff + m * 2048 + k * 1024); } while (0)
#define PG8_LDB(dst, b, h) do { _Pragma("unroll") for (int n = 0; n < 2; ++n) _Pragma("unroll") for (int k = 0; k < 2; ++k) dst[n][k] = *(const LAS bf16x8*)(lds + PG8_SB(b, h) + boff + n * 2048 + k * 1024); } while (0)
#define PG8_MMA(ai, bj, At, Bt) do { __builtin_amdgcn_s_setprio(1); _Pragma("unroll") for (int m = 0; m < 4; ++m) _Pragma("unroll") for (int n = 0; n < 2; ++n) _Pragma("unroll") for (int k = 0; k < 2; ++k) \
        acc[ai][bj][m][n] = __builtin_amdgcn_mfma_f32_16x16x32_f16(__builtin_bit_cast(f16x8, Bt[n][k]), __builtin_bit_cast(f16x8, At[m][k]), acc[ai][bj][m][n], 0, 0, 0); __builtin_amdgcn_s_setprio(0); } while (0)
#define PG8_WAIT_V(n) asm volatile("s_waitcnt vmcnt(" #n ")" ::: "memory")
#define PG8_WAIT_L(n) asm volatile("s_waitcnt lgkmcnt(" #n ")" ::: "memory")
#define PG8_BAR __builtin_amdgcn_s_barrier()
#define PG8_SCHED __builtin_amdgcn_sched_barrier(0)
    Unit cur, nxt; int ui = 0;
    if (!S.next(0, cur)) return;
    f32x4 acc[2][2][4][2];
#pragma unroll
    for (int a = 0; a < 2; ++a)
#pragma unroll
        for (int b = 0; b < 2; ++b)
#pragma unroll
            for (int m = 0; m < 4; ++m)
#pragma unroll
                for (int n = 0; n < 2; ++n) acc[a][b][m][n] = (f32x4){0.f, 0.f, 0.f, 0.f};
    bf16x8 At[4][2], B0[2][2], B1[2][2];
    const char* cA = (const char*)g.A + (size_t)cur.pm * tstep; const char* cB = (const char*)g.Bt + (size_t)cur.pn * tstep;
    S.a_ready(cur);
    PG8_STAGE(PG8_SB(0, 0), cB, voffB); PG8_STAGE(PG8_SB(0, 1), cB + hstep, voffB); PG8_STAGE(PG8_SA(0, 0), cA, voffA); PG8_STAGE(PG8_SA(0, 1), cA + hstep, voffA);
    if (wr == 1) PG8_BAR;
    PG8_WAIT_V(2); PG8_BAR;
    PG8_STAGE(PG8_SB(1, 0), cB + kstep, voffB); PG8_STAGE(PG8_SA(1, 0), cA + kstep, voffA); PG8_STAGE(PG8_SB(1, 1), cB + hstep + kstep, voffB);
    PG8_WAIT_V(6); PG8_BAR;
    for (;;) {
        const bool has_next = S.next(ui + 1, nxt);
        const char* nA = has_next ? (const char*)g.A + (size_t)nxt.pm * tstep : cA; const char* nB = has_next ? (const char*)g.Bt + (size_t)nxt.pn * tstep : cB;
        for (int t = 0; t < nt; t += 2) {
            const bool last = (t == nt - 2);
            const char* a1 = cA + (size_t)(t + 1) * kstep;
            const char* a2 = last ? nA : cA + (size_t)(t + 2) * kstep; const char* b2 = last ? nB : cB + (size_t)(t + 2) * kstep;
            const char* a3 = a2 + kstep; const char* b3 = b2 + kstep;
            if (last && has_next) S.a_ready(nxt);
            PG8_LDB(B0, 0, 0); PG8_LDB(B1, 0, 1); PG8_SCHED; PG8_LDA(At, 0, 0); PG8_STAGE(PG8_SA(1, 1), a1 + hstep, voffA);
            PG8_WAIT_V(8); PG8_WAIT_L(0); PG8_BAR; PG8_MMA(0, 0, At, B0); PG8_MMA(0, 1, At, B1); PG8_BAR; PG8_SCHED;
            PG8_LDA(At, 0, 1); PG8_STAGE(PG8_SB(0, 0), b2, voffB); PG8_STAGE(PG8_SB(0, 1), b2 + hstep, voffB); PG8_STAGE(PG8_SA(0, 0), a2, voffA);
            PG8_WAIT_V(8); PG8_WAIT_L(0); PG8_BAR; PG8_MMA(1, 0, At, B0); PG8_MMA(1, 1, At, B1); PG8_BAR; PG8_SCHED;
            PG8_LDB(B0, 1, 0); PG8_LDB(B1, 1, 1); PG8_SCHED; PG8_LDA(At, 1, 0); PG8_STAGE(PG8_SA(0, 1), a2 + hstep, voffA);
            PG8_WAIT_V(8); PG8_WAIT_L(0); PG8_BAR; PG8_MMA(0, 0, At, B0); PG8_MMA(0, 1, At, B1); PG8_BAR; PG8_SCHED;
            PG8_LDA(At, 1, 1); PG8_STAGE(PG8_SB(1, 0), b3, voffB); PG8_STAGE(PG8_SB(1, 1), b3 + hstep, voffB); PG8_STAGE(PG8_SA(1, 0), a3, voffA);
            PG8_WAIT_V(8); PG8_WAIT_L(0); PG8_BAR; PG8_MMA(1, 0, At, B0); PG8_MMA(1, 1, At, B1); PG8_BAR; PG8_SCHED;
        }
        if constexpr (ALIGN_EPI) { if (wr == 0) PG8_BAR; }
        if constexpr (!Epi::AFTER_DRAIN) { E(acc, cur, wr, wc, fr, fq); S.done(cur); }
        if (!has_next) break;
#pragma unroll
        for (int a = 0; a < 2; ++a)
#pragma unroll
            for (int b = 0; b < 2; ++b)
#pragma unroll
                for (int m = 0; m < 4; ++m)
#pragma unroll
                    for (int n = 0; n < 2; ++n) acc[a][b][m][n] = (f32x4){0.f, 0.f, 0.f, 0.f};
        cur = nxt; cA = nA; cB = nB; ++ui;
        if constexpr (ALIGN_EPI) { if (wr == 1) PG8_BAR; }
    }
    PG8_WAIT_V(0);
    if constexpr (!ALIGN_EPI) { if (wr == 0) PG8_BAR; }
    PG8_BAR;
    if constexpr (Epi::AFTER_DRAIN) { E.fused(acc, cur, wr, wc, fr, fq, lds, wid, lane); S.done(cur); }
#undef PG8_SA
#undef PG8_SB
#undef PG8_STAGE
#undef PG8_LDA
#undef PG8_LDB
#undef PG8_MMA
#undef PG8_WAIT_V
#undef PG8_WAIT_L
#undef PG8_BAR
#undef PG8_SCHED
}
}

#define XB_TMO      128
#define XB_XCNT(j)  (256  + 64 * (j))
#define XB_XSUB(j)  (1280 + 64 * (j))
#define XB_XGEN(j)  (2304 + 64 * (j))
#define XB_TOP      3328
#define XB_TOPGEN   3392
#define XCD_BAR_WORDS 3456
#define XB_SPIN_CAP (1u << 22)
__device__ __forceinline__ unsigned xb_ld(unsigned* p)              { return __hip_atomic_load(p, __ATOMIC_RELAXED, __HIP_MEMORY_SCOPE_AGENT); }
__device__ __forceinline__ unsigned xb_add(unsigned* p, unsigned v) { return __hip_atomic_fetch_add(p, v, __ATOMIC_RELAXED, __HIP_MEMORY_SCOPE_AGENT); }
__device__ __forceinline__ unsigned xb_xcc_id() { return (unsigned)__builtin_amdgcn_s_getreg((3 << 11) | 20) & 0xFu; }
#define XB_SPIN(cond, bar) do { unsigned _sp = 0; while (cond) { __builtin_amdgcn_s_sleep(1); \
    if ((++_sp & 255u) == 0u) { if (xb_ld(&(bar)[XB_TMO])) break; if (_sp > XB_SPIN_CAP) { atomicAdd(&(bar)[XB_TMO], 1u); break; } } } } while (0)
struct XcdBarrier { unsigned* bar; unsigned x; volatile LAS unsigned* st; };
__device__ __forceinline__ XcdBarrier xcd_barrier_post(unsigned* bar, volatile LAS unsigned* st) {
    XcdBarrier b; b.bar = bar; b.x = xb_xcc_id(); b.st = st;
    if (threadIdx.x == 0) (void)xb_add(&bar[XB_XCNT(b.x)], 1u);
    return b;
}
__device__ __forceinline__ void xcd_barrier_complete(unsigned* bar, unsigned x, unsigned& nloc, unsigned& nx) {
    const unsigned G = gridDim.x * gridDim.y * gridDim.z;
    unsigned sum, cnt, mine, sp = 0u;
    for (;;) {
        sum = 0u; cnt = 0u; mine = 0u;
#pragma unroll
        for (unsigned j = 0; j < 16; ++j) { const unsigned c = xb_ld(&bar[XB_XCNT(j)]); sum += c; cnt += (c > 0u) ? 1u : 0u; mine = (j == x) ? c : mine; }
        if (sum == G) break;
        __builtin_amdgcn_s_sleep(1);
        if ((++sp & 255u) == 0u) { if (xb_ld(&bar[XB_TMO])) break; if (sp > XB_SPIN_CAP) { atomicAdd(&bar[XB_TMO], 1u); break; } }
    }
    nloc = mine > 0u ? mine : 1u; nx = cnt > 0u ? cnt : 1u;
}
__device__ __forceinline__ void xcd_barrier(const XcdBarrier& b) {
    asm volatile("s_waitcnt vmcnt(0)" ::: "memory");
    __syncthreads();
    if (threadIdx.x == 0) {
        unsigned* bar = b.bar;
        __builtin_amdgcn_s_waitcnt(0);
        unsigned nloc = b.st[0], nx = b.st[1];
        if (nloc == 0u) { xcd_barrier_complete(bar, b.x, nloc, nx); b.st[0] = nloc; b.st[1] = nx; }
        const unsigned old = xb_add(&bar[XB_XSUB(b.x)], 1u);
        const unsigned gen = old / nloc;
        if (old + 1u == (gen + 1u) * nloc) {
            __builtin_amdgcn_fence(__ATOMIC_RELEASE, "agent");
            asm volatile("s_waitcnt vmcnt(0)" ::: "memory");
            const unsigned og = xb_add(&bar[XB_TOP], 1u);
            const unsigned tg = og / nx;
            if (og + 1u == (tg + 1u) * nx) xb_add(&bar[XB_TOPGEN], 1u);
            else XB_SPIN(xb_ld(&bar[XB_TOPGEN]) == tg, bar);
            __builtin_amdgcn_fence(__ATOMIC_ACQUIRE, "agent");
            xb_add(&bar[XB_XGEN(b.x)], 1u);
            asm volatile("s_waitcnt vmcnt(0)" ::: "memory");
        } else {
            XB_SPIN(xb_ld(&bar[XB_XGEN(b.x)]) == gen, bar);
            __builtin_amdgcn_fence(__ATOMIC_ACQUIRE, "agent");
            asm volatile("s_waitcnt vmcnt(0)" ::: "memory");
        }
    }
    __syncthreads();
}

struct Params {
    const float* in[24];
    float* out;
    unsigned char* ws;
};
enum { I_X = 0, I_LN1G, I_LN1B, I_F1G, I_F1U, I_F1D, I_WIN, I_BGATE, I_POOLW, I_POOLS, I_CPK, I_CKW1, I_CKW2, I_CPV, I_CVW1, I_CVW2, I_WOUT, I_LN2G, I_LN2B, I_F2G, I_F2U, I_F2D, I_LN3G, I_LN3B };

template <bool F16, class RowMap>
__device__ __forceinline__ void transpose_cvt(LAS float* tile  , const float* src, int K, int N, RowMap rm, int owner = -1) {
    const int tK = (K + 63) / 64, tN = (N + 63) / 64, tid = tid_fresh();
    const int tbeg = owner < 0 ? (int)blockIdx.x : ((int)blockIdx.x == owner ? 0 : tK * tN), tinc = owner < 0 ? (int)gridDim.x : 1;
    for (int t = tbeg; t < tK * tN; t += 4 * tinc) {
        f32x4 v[4][2];
#pragma unroll
        for (int b = 0; b < 4; ++b) { const int tb = t + b * tinc; const int k0 = (tb / tN) * 64, n0 = (tb % tN) * 64;
#pragma unroll
            for (int i = 0; i < 2; ++i) { const int kr = (tid >> 4) + 32 * i, nc = 4 * (tid & 15);
                v[b][i] = (f32x4){0.f, 0.f, 0.f, 0.f}; if (tb < tK * tN && k0 + kr < K && n0 + nc < N) v[b][i] = *(const f32x4*)(src + (size_t)(k0 + kr) * N + n0 + nc); } }
#pragma unroll
        for (int b = 0; b < 4; ++b)
#pragma unroll
            for (int i = 0; i < 2; ++i) { const int kr = (tid >> 4) + 32 * i, nc = 4 * (tid & 15); LAS float* tl = tile + b * (64 * 65);
                tl[kr * 65 + nc] = v[b][i][0]; tl[kr * 65 + nc + 1] = v[b][i][1]; tl[kr * 65 + nc + 2] = v[b][i][2]; tl[kr * 65 + nc + 3] = v[b][i][3]; }
        __syncthreads();
#pragma unroll
        for (int b = 0; b < 4; ++b) { const int tb = t + b * tinc; const int k0 = (tb / tN) * 64, n0 = (tb % tN) * 64; const LAS float* tl = tile + b * (64 * 65);
          const int nr = tid >> 3, kc = 8 * (tid & 7);
          if (tb < tK * tN && n0 + nr < N && k0 + kc < K) { bf16_t* d = rm(n0 + nr);
              if (d) { u32x4 w;
                       if (F16) { w.x = cvt_pk_f16_b(tl[(kc + 0) * 65 + nr], tl[(kc + 1) * 65 + nr]); w.y = cvt_pk_f16_b(tl[(kc + 2) * 65 + nr], tl[(kc + 3) * 65 + nr]);
                                  w.z = cvt_pk_f16_b(tl[(kc + 4) * 65 + nr], tl[(kc + 5) * 65 + nr]); w.w = cvt_pk_f16_b(tl[(kc + 6) * 65 + nr], tl[(kc + 7) * 65 + nr]); }
                       else     { w.x = cvt_pk_bf16(tl[(kc + 0) * 65 + nr], tl[(kc + 1) * 65 + nr]); w.y = cvt_pk_bf16(tl[(kc + 2) * 65 + nr], tl[(kc + 3) * 65 + nr]);
                                  w.z = cvt_pk_bf16(tl[(kc + 4) * 65 + nr], tl[(kc + 5) * 65 + nr]); w.w = cvt_pk_bf16(tl[(kc + 6) * 65 + nr], tl[(kc + 7) * 65 + nr]); }
                       *(u32x4*)(d + k0 + kc) = w; } } }
        __syncthreads();
    }
}

__device__ void p0_phase(const Params& p, LAS unsigned char* lds) {
    LAS float* tile = (LAS float*)lds;
    unsigned char* ws = p.ws;
    const int tid = tid_fresh();
    for (int l = 0; l < 2; ++l) {
        for (int f = 0; f < 2; ++f) {
            bf16_t* wgu = (bf16_t*)(ws + WS_WGU + (size_t)(l * 2 + f) * SZ_WGU);
            bf16_t* wdn = (bf16_t*)(ws + WS_WDN + (size_t)(l * 2 + f) * SZ_WDN);
            const float* sg = p.in[f ? I_F2G : I_F1G] + (size_t)l * DM * DFF;
            const float* su = p.in[f ? I_F2U : I_F1U] + (size_t)l * DM * DFF;
            const float* sd = p.in[f ? I_F2D : I_F1D] + (size_t)l * DFF * DM;
            transpose_cvt<true>(tile, sg, DM, DFF, [=](int n) { return wgu + (size_t)((n >> 7) * 256 + (n & 127)) * DM; });
            transpose_cvt<true>(tile, su, DM, DFF, [=](int n) { return wgu + (size_t)((n >> 7) * 256 + 128 + (n & 127)) * DM; });
            transpose_cvt<true>(tile, sd, DFF, DM, [=](int n) { return wdn + (size_t)n * DFF; });
        }
        bf16_t* win = (bf16_t*)(ws + WS_WIN + (size_t)l * SZ_WIN);
        bf16_t* wvt = (bf16_t*)(ws + WS_WVT + (size_t)l * SZ_WVT);
        transpose_cvt<true>(tile, p.in[I_WIN] + (size_t)l * DM * 2200, DM, 2200, [=](int n) -> bf16_t* {
            if (n < 1600) return win + (size_t)n * DM;
            if (n < 1792) return wvt + (size_t)(n - 1600) * DM;
            if (n < 1984) return win + (size_t)(n - 1792 + C_KW) * DM;
            if (n < 2176) return wvt + (size_t)(n - 1984 + 192) * DM;
            return win + (size_t)(n - 2176 + C_G) * DM; });
        { u32x4 z = {0u, 0u, 0u, 0u};
          u32x4* a = (u32x4*)(win + (size_t)1816 * DM); const size_t na = (size_t)(2048 - 1816) * DM * 2 / 16;
          for (size_t i = (size_t)blockIdx.x * 512 + tid; i < na; i += (size_t)gridDim.x * 512) a[i] = z;
          u32x4* b = (u32x4*)(wvt + (size_t)384 * DM); const size_t nb = (size_t)(512 - 384) * DM * 2 / 16;
          for (size_t i = (size_t)blockIdx.x * 512 + tid; i < nb; i += (size_t)gridDim.x * 512) b[i] = z; }
        bf16_t* wout = (bf16_t*)(ws + WS_WOUT + (size_t)l * SZ_WOUT);
        transpose_cvt<true>(tile, p.in[I_WOUT] + (size_t)l * DM * DM, DM, DM, [=](int n) { return wout + (size_t)n * DM; });
        for (int kv = 0; kv < 2; ++kv) {
            bf16_t* wc1 = (bf16_t*)(ws + WS_WC1 + (size_t)(l * 2 + kv) * SZ_WC1);
            bf16_t* wc2 = (bf16_t*)(ws + WS_WC2 + (size_t)(l * 2 + kv) * SZ_WC2);
            transpose_cvt<false>(tile, p.in[kv ? I_CVW1 : I_CKW1] + (size_t)l * 3072 * 96, 3072, 96, [=](int n) { return wc1 + (size_t)n * 3072; });
            transpose_cvt<false>(tile, p.in[kv ? I_CVW2 : I_CKW2] + (size_t)l * 96 * 96, 96, 96, [=](int n) { return wc2 + (size_t)n * 96; }, 8 + l * 2 + kv);
        }
    }
    if (blockIdx.x < 128) {
        const int which = blockIdx.x >> 5, chunk = blockIdx.x & 31, l = which >> 1, kv = which & 1;
        const float* pos = p.in[kv ? I_CPV : I_CPK] + (size_t)l * 3072;
        const float* w1 = p.in[kv ? I_CVW1 : I_CKW1] + (size_t)l * 3072 * 96;
        float* part = (float*)(ws + WS_POSP) + (size_t)(which * 32 + chunk) * 96;
        LAS float* red = (LAS float*)lds;
        const int c = tid % 96, sub = tid / 96;
        float s = 0.f;
        if (sub < 5) { for (int k = chunk * 96 + sub; k < chunk * 96 + 96; k += 5) s += pos[k] * w1[(size_t)k * 96 + c]; red[sub * 96 + c] = s; }
        __syncthreads();
        if (tid < 96) part[tid] = red[tid] + red[96 + tid] + red[192 + tid] + red[288 + tid] + red[384 + tid];
        __syncthreads();
    }
    { const f32x4* x4 = (const f32x4*)p.in[I_X]; u32x2* xb = (u32x2*)(ws + WS_XB); const size_t n4 = (size_t)MTOK * DM / 4;
      const size_t stride = (size_t)gridDim.x * 512;
      size_t i = (size_t)blockIdx.x * 512 + tid;
      for (; i + 7 * stride < n4; i += 8 * stride) { f32x4 v[8];
#pragma unroll
          for (int k = 0; k < 8; ++k) v[k] = x4[i + k * stride];
#pragma unroll
          for (int k = 0; k < 8; ++k) { u32x2 w; w.x = cvt_pk_f16(v[k][0], v[k][1]); w.y = cvt_pk_f16(v[k][2], v[k][3]); xb[i + k * stride] = w; } }
      for (; i < n4; i += stride) { const f32x4 v = x4[i]; u32x2 w; w.x = cvt_pk_f16(v[0], v[1]); w.y = cvt_pk_f16(v[2], v[3]); xb[i] = w; } }
}

__device__ __forceinline__ float gelu_tanh(float x) { const float u = 0.7978845608028654f * (x + 0.044715f * x * x * x); const float t = 1.0f - 2.0f / (1.0f + __expf(2.0f * u)); return 0.5f * x * (1.0f + t); }

__device__ void compress_item(LAS unsigned char* lds, int item, const bf16_t* proj, const unsigned char* ws, int l, bf16_t* kcmp, bf16_t* vcmpT) {
    const int tid = tid_fresh(), wid = tid >> 6, lane = tid & 63, c16 = lane & 15, hh = lane >> 4;
    const int rt = item & 31, kv = (item >> 5) & 1, bg = item >> 6, b = bg >> 1, g = bg & 1;
    const int n0 = 32 * rt, tok0 = 16 * n0, col0 = (kv ? C_VC : C_KC) + g * 96;
    const bf16_t* w1t = (const bf16_t*)(ws + WS_WC1 + (size_t)(l * 2 + kv) * SZ_WC1);
    const bf16_t* w2t = (const bf16_t*)(ws + WS_WC2 + (size_t)(l * 2 + kv) * SZ_WC2);
    const float* posp = (const float*)(ws + WS_POSP) + (size_t)(l * 2 + kv) * 32 * 96;
    { u32x4 v[13];
#pragma unroll
      for (int k = 0; k < 13; ++k) { const int i = tid + 512 * k; if (i < 528 * 12) { const int tl = i / 12, ch = i % 12; int tok = tok0 + tl; tok = tok < SEQ ? tok : SEQ - 1;
          v[k] = *(const u32x4*)(proj + (size_t)(b * SEQ + tok) * NPROJ + col0 + ch * 8); } }
#pragma unroll
      for (int k = 0; k < 13; ++k) { const int i = tid + 512 * k; if (i < 528 * 12) { const int tl = i / 12, ch = i % 12;
          *(LAS u32x4*)(lds + ((tl & 15) * 33 + (tl >> 4)) * 208 + ch * 16) = v[k]; } } }
    __syncthreads();
    f32x4 acc[2][6];
#pragma unroll
    for (int a = 0; a < 2; ++a)
#pragma unroll
        for (int c = 0; c < 6; ++c) acc[a][c] = (f32x4){0.f, 0.f, 0.f, 0.f};
    for (int jj = 0; jj < 4; ++jj) { const int j = 4 * wid + jj, r = j & 15, qoff = j >> 4;
#pragma unroll
        for (int ds = 0; ds < 3; ++ds) {
            bf16x8 a[2];
#pragma unroll
            for (int r2 = 0; r2 < 2; ++r2) a[r2] = *(const LAS bf16x8*)(lds + (r * 33 + 16 * r2 + c16 + qoff) * 208 + (32 * ds + 8 * hh) * 2);
#pragma unroll
            for (int ct = 0; ct < 6; ++ct) { const bf16x8 bf = *(const bf16x8*)(w1t + (size_t)(16 * ct + c16) * 3072 + j * 96 + 32 * ds + 8 * hh);
#pragma unroll
                for (int r2 = 0; r2 < 2; ++r2) acc[r2][ct] = __builtin_amdgcn_mfma_f32_16x16x32_bf16(a[r2], bf, acc[r2][ct], 0, 0, 0); }
        } }
    __syncthreads();
    LAS float* part = (LAS float*)lds;
#pragma unroll
    for (int r2 = 0; r2 < 2; ++r2)
#pragma unroll
        for (int ct = 0; ct < 6; ++ct)
#pragma unroll
            for (int r = 0; r < 4; ++r) part[(wid * 32 + 16 * r2 + 4 * hh + r) * 96 + 16 * ct + c16] = acc[r2][ct][r];
    LAS float* posw = (LAS float*)(lds + 98304 + 32 * 208);
    if (tid < 96) { float ps = 0.f;
#pragma unroll 8
        for (int ch = 0; ch < 32; ++ch) ps += posp[ch * 96 + tid];
        posw[tid] = ps; }
    __syncthreads();
    LAS unsigned char* hsm = lds + 98304;
    for (int idx = tid; idx < 32 * 96; idx += 512) { const int n = idx / 96, cc = idx % 96; float s = posw[cc];
#pragma unroll
        for (int w = 0; w < 8; ++w) s += part[(w * 32 + n) * 96 + cc];
        *(LAS bf16_t*)(hsm + n * 208 + cc * 2) = f2bf(gelu_tanh(s)); }
    __syncthreads();
    if (wid < 6) { const int ct = wid;
#pragma unroll
        for (int r2 = 0; r2 < 2; ++r2) { f32x4 o = {0.f, 0.f, 0.f, 0.f};
#pragma unroll
            for (int ks = 0; ks < 3; ++ks) { const bf16x8 a = *(const LAS bf16x8*)(hsm + (16 * r2 + c16) * 208 + (32 * ks + 8 * hh) * 2);
                const bf16x8 bf = *(const bf16x8*)(w2t + (size_t)(16 * ct + c16) * 96 + 32 * ks + 8 * hh);
                o = __builtin_amdgcn_mfma_f32_16x16x32_bf16(a, bf, o, 0, 0, 0); }
#pragma unroll
            for (int r = 0; r < 4; ++r) { const int n = n0 + 16 * r2 + 4 * hh + r, cc = 16 * ct + c16; const bf16_t v = (n == 1023) ? (bf16_t)0 : f2bf(o[r]);
                if (kv == 0) kcmp[(size_t)(bg * 1024 + n) * 96 + cc] = v; else vcmpT[(size_t)((bg * 32 + rt) * 96 + cc) * 32 + (n - n0)] = v; } } }
    __syncthreads();
}

__device__ void pool_item(LAS unsigned char* lds, int item, const bf16_t* proj, const float* pool_w, const float* pool_scale, bf16_t* concat) {
    const int tid = tid_fresh();
    const int row0 = item * 64, tpos0 = row0 & (SEQ - 1);
    LAS bf16_t* ub = (LAS bf16_t*)lds;
    LAS float* pT = (LAS float*)(lds + 40448);
    { u32x4 v[5];
#pragma unroll
      for (int k = 0; k < 5; ++k) { const int i = tid + 512 * k; v[k] = (u32x4){0u, 0u, 0u, 0u}; if (i < 79 * 32) { const int rr = i >> 5, ch = i & 31; const int tp = tpos0 - 15 + rr;
          if (tp >= 0) v[k] = *(const u32x4*)(proj + (size_t)(row0 - 15 + rr) * NPROJ + ch * 8); } }
#pragma unroll
      for (int k = 0; k < 5; ++k) { const int i = tid + 512 * k; if (i < 79 * 32) { const int rr = i >> 5, ch = i & 31; *(LAS u32x4*)(lds + rr * 512 + ch * 16) = v[k]; } } }
    __syncthreads();
#pragma unroll 4
    for (int i = 0; i < 32; ++i) { const int idx = tid + 512 * i, ch = idx & 255, tl = idx >> 8, g = ch >> 6, w = 2 << g;
        const int tp = tpos0 + tl; const float cnt = (float)((tp + 1) < w ? (tp + 1) : w);
        float s = 0.f; for (int k = 0; k < w; ++k) s += bf2f(ub[(15 + tl - k) * 256 + ch]);
        pT[ch * 68 + tl] = s / cnt - bf2f(ub[(15 + tl) * 256 + ch]); }
    __syncthreads();
    { const int co = tid & 255, th = tid >> 8, g = co >> 6, dd = co & 63;
      float acc[32];
#pragma unroll
      for (int i = 0; i < 32; ++i) acc[i] = 0.f;
      float wreg[64];
#pragma unroll
      for (int cc = 0; cc < 64; ++cc) wreg[cc] = pool_w[(size_t)(g * 64 + cc) * 64 + dd];
#pragma unroll
      for (int cc = 0; cc < 64; ++cc) { const float wv = wreg[cc];
#pragma unroll
          for (int i4 = 0; i4 < 8; ++i4) { const f32x4 pv = *(const LAS f32x4*)(pT + (g * 64 + cc) * 68 + th * 32 + 4 * i4);
              acc[4 * i4 + 0] += pv[0] * wv; acc[4 * i4 + 1] += pv[1] * wv; acc[4 * i4 + 2] += pv[2] * wv; acc[4 * i4 + 3] += pv[3] * wv; } }
      const float sc = pool_scale[co];
#pragma unroll
      for (int i = 0; i < 32; ++i) concat[(size_t)(row0 + th * 32 + i) * DM + co] = f2h(acc[i] * sc); }
    __syncthreads();
}

constexpr int A_KSZ = 64 * 192, A_VSZ = 96 * 128, A_BUF = A_KSZ + A_VSZ,
              A_IMP = 3 * A_BUF, A_IMPW = 260, A_PLAN = LDS_BYTES - 16 - 512 * 16, A_SEL = A_PLAN - 64 * 8 * 4, A_END = LDS_BYTES - 16;
constexpr int SLC_CH = 3;
static_assert(A_IMP + 64 * A_IMPW * 4 <= A_SEL && 2 * SLC_CH * A_BUF <= A_SEL, "attn lds");
constexpr float SM_SC = 0.10206207261596577f * 1.4426950408889634f;
constexpr float NEGB = -1e30f;
enum { MODE_WIN = 0, MODE_CMP = 1, MODE_SLC = 2 };

template <bool VCH>
__device__ __forceinline__ void dma_plan(LAS unsigned char* lds, unsigned kstride, unsigned vstride, int wid, int lane, int tid) {
    u32x4 g = {0u, 0u, 0u, 0u};
#pragma unroll
    for (int j = 0; j < 3; ++j) { const int sidx = wid + 8 * j; const bool isK = sidx < 12; const int piece = isK ? sidx : sidx - 12; const int o = piece * 1024 + 16 * lane;
        unsigned goff;
        if (isK) { const int r = o / 192, ph = (o % 192) >> 4, f = (4 - ((r >> 2) & 3)) & 3, u = (ph & ~3) | ((ph & 3) ^ f); goff = (unsigned)r * kstride + u * 8; }
        else { const int d = o >> 7, ph = (o & 127) >> 4, w = ph ^ ((d >> 1) & 7); goff = VCH ? (unsigned)(((w >> 2) * 96 + d) * 32 + (w & 3) * 8) : (unsigned)d * vstride + w * 8; }
        g[j] = goff; }
    *(LAS u32x4*)(lds + A_PLAN + tid * 16) = g;
}
template <bool VCH>
__device__ __forceinline__ void dma_issue(LAS unsigned char* lds, int buf, int T, const bf16_t* kb, unsigned kstride, const bf16_t* vb, int wid, int tid) {
    const u32x4 g = *(const LAS u32x4*)(lds + A_PLAN + tid * 16);
    const __amdgpu_buffer_rsrc_t rk = __builtin_amdgcn_make_buffer_rsrc((void*)kb, (short)0, 0x7fffffff, 0x00020000);
    const __amdgpu_buffer_rsrc_t rv = __builtin_amdgcn_make_buffer_rsrc((void*)vb, (short)0, 0x7fffffff, 0x00020000);
    const int ko = T * 128 * (int)kstride, vo = T * (VCH ? 12288 : 128);
#pragma unroll
    for (int j = 0; j < 3; ++j) { const int sidx = wid + 8 * j;
        const bool isK = sidx < 12; const int piece = isK ? sidx : sidx - 12;
        LAS void* dst = (LAS void*)(lds + buf * A_BUF + (isK ? 0 : A_KSZ) + piece * 1024);
        if (isK) __builtin_amdgcn_raw_ptr_buffer_load_lds(rk, dst, 16, (int)(g[j] * 2u), ko, 0, 0);
        else     __builtin_amdgcn_raw_ptr_buffer_load_lds(rv, dst, 16, (int)(g[j] * 2u), vo, 0, 0); }
}

template <int MODE>
__device__ __forceinline__ bool key_valid(int kk, int tok) {
    if (MODE == MODE_WIN) return (kk <= tok) && (tok - kk < 512);
    if (MODE == MODE_CMP) return (16 * kk + 31) <= tok;
    return kk <= tok;
}

template <int MODE, int QM>
__device__ __forceinline__ void tile_compute(LAS const unsigned char* ks, LAS const unsigned char* vs, int T, bool masked, const bf16x8 (&qf)[2][3], const int (&tok)[2], const bool (&selq)[2],
                                             f32x4 (&O)[2][6], float (&m)[2], float (&ls)[2], int c16, int hh) {
    const int kro = c16 * 192 + ((hh ^ ((4 - ((c16 >> 2) & 3)) & 3)) << 4);
    int vro[4];
#pragma unroll
    for (int j = 0; j < 4; ++j) vro[j] = c16 * 128 + ((((2 * j) | (hh >> 1)) ^ ((c16 >> 1) & 7)) << 4) + 8 * (hh & 1);
    f32x4 s[2][4];
    __builtin_amdgcn_s_setprio(1);
#pragma unroll
    for (int kt = 0; kt < 4; ++kt) {
#pragma unroll
        for (int k3 = 0; k3 < 3; ++k3) { const bf16x8 a = *(const LAS bf16x8*)(ks + kro + kt * 3072 + k3 * 64);
#pragma unroll
            for (int q = 0; q < 2; ++q) if ((QM >> q) & 1) s[q][kt] = __builtin_amdgcn_mfma_f32_16x16x32_bf16(a, qf[q][k3], (k3 == 0) ? (f32x4){0.f, 0.f, 0.f, 0.f} : s[q][kt], 0, 0, 0); } }
    __builtin_amdgcn_s_setprio(0);
    bf16x8 pb[2][2];
#pragma unroll
    for (int q = 0; q < 2; ++q) if ((QM >> q) & 1) {
        if (masked) {
#pragma unroll
            for (int kt = 0; kt < 4; ++kt)
#pragma unroll
                for (int r = 0; r < 4; ++r) { const int kk = 64 * T + 16 * kt + 4 * hh + r; s[q][kt][r] = key_valid<MODE>(kk, tok[q]) ? s[q][kt][r] : -1e35f; }
        }
        float mloc = -1e20f;
#pragma unroll
        for (int kt = 0; kt < 4; ++kt)
#pragma unroll
            for (int r = 0; r < 4; ++r) mloc = fmaxf(mloc, s[q][kt][r]);
        if (MODE == MODE_SLC) mloc = selq[q] ? mloc : -1e20f;
        mloc = xr32_max(xr16_max(mloc));
        const float mn = fmaxf(m[q], mloc), al = __builtin_amdgcn_exp2f((m[q] - mn) * SM_SC); m[q] = mn;
        const float nb = (MODE == MODE_SLC && !selq[q]) ? -1e35f : -mn * SM_SC;
        float lsum = 0.f;
#pragma unroll
        for (int kt = 0; kt < 4; ++kt)
#pragma unroll
            for (int r = 0; r < 4; ++r) { const float pv = __builtin_amdgcn_exp2f(fmaf(s[q][kt][r], SM_SC, nb)); s[q][kt][r] = pv; lsum += pv; }
        ls[q] = ls[q] * al + lsum;
        if (__builtin_amdgcn_ballot_w64(al != 1.0f) != 0ull) {
#pragma unroll
            for (int dt = 0; dt < 6; ++dt) O[q][dt] *= al; }
#pragma unroll
        for (int s2 = 0; s2 < 2; ++s2) { u32x4 w; w.x = cvt_pk_bf16(s[q][2 * s2][0], s[q][2 * s2][1]); w.y = cvt_pk_bf16(s[q][2 * s2][2], s[q][2 * s2][3]);
            w.z = cvt_pk_bf16(s[q][2 * s2 + 1][0], s[q][2 * s2 + 1][1]); w.w = cvt_pk_bf16(s[q][2 * s2 + 1][2], s[q][2 * s2 + 1][3]); pb[q][s2] = __builtin_bit_cast(bf16x8, w); }
    }
    __builtin_amdgcn_s_setprio(1);
#pragma unroll
    for (int dt = 0; dt < 6; ++dt)
#pragma unroll
        for (int s2 = 0; s2 < 2; ++s2) { const u32x2 lo = *(const LAS u32x2*)(vs + dt * 2048 + vro[2 * s2]), hi = *(const LAS u32x2*)(vs + dt * 2048 + vro[2 * s2 + 1]);
            u32x4 w; w.x = lo.x; w.y = lo.y; w.z = hi.x; w.w = hi.y; const bf16x8 a = __builtin_bit_cast(bf16x8, w);
#pragma unroll
            for (int q = 0; q < 2; ++q) if ((QM >> q) & 1) O[q][dt] = __builtin_amdgcn_mfma_f32_16x16x32_bf16(a, pb[q][s2], O[q][dt], 0, 0, 0); }
    __builtin_amdgcn_s_setprio(0);
}

__device__ __forceinline__ void imp_compute(LAS const unsigned char* ks, int T, const bf16x8 (&qf)[2][3], const int (&tok)[2], const int (&tokl)[2], const float (&m)[2], const float (&rl)[2], LAS float* imp, int c16, int hh) {
    const int kro = c16 * 192 + ((hh ^ ((4 - ((c16 >> 2) & 3)) & 3)) << 4);
#pragma unroll
    for (int kt = 0; kt < 4; ++kt) { f32x4 s[2] = {{0.f, 0.f, 0.f, 0.f}, {0.f, 0.f, 0.f, 0.f}};
#pragma unroll
        for (int k3 = 0; k3 < 3; ++k3) { const bf16x8 a = *(const LAS bf16x8*)(ks + kro + kt * 3072 + k3 * 64);
#pragma unroll
            for (int q = 0; q < 2; ++q) s[q] = __builtin_amdgcn_mfma_f32_16x16x32_bf16(a, qf[q][k3], s[q], 0, 0, 0); }
#pragma unroll
        for (int q = 0; q < 2; ++q) { float pv[4];
#pragma unroll
            for (int r = 0; r < 4; ++r) { const int kk = 64 * T + 16 * kt + 4 * hh + r; pv[r] = key_valid<MODE_CMP>(kk, tok[q]) ? __builtin_amdgcn_exp2f((s[q][r] - m[q]) * SM_SC) * rl[q] : 0.f; }
            float a = (pv[0] + pv[1]) + (pv[2] + 0.5f * pv[3]), bb = 0.5f * pv[3];
            a += dpp_f<DPP_XOR1>(a); a += dpp_f<DPP_XOR2>(a); bb += dpp_f<DPP_XOR1>(bb); bb += dpp_f<DPP_XOR2>(bb);
            if ((c16 & 3) == 0) { const int jj = 16 * T + 4 * kt + hh; LAS float* ip = imp + tokl[q] * A_IMPW + jj;
                __hip_atomic_fetch_add(ip, a, __ATOMIC_RELAXED, __HIP_MEMORY_SCOPE_WORKGROUP); __hip_atomic_fetch_add(ip + 1, bb, __ATOMIC_RELAXED, __HIP_MEMORY_SCOPE_WORKGROUP); } } }
}

template <int MODE, bool IMP, int NBS, int CH>
__device__ __forceinline__ void flash_branch(LAS unsigned char* lds, const bf16_t* kb, unsigned kstride, const bf16_t* vb, unsigned vstride, int T_lo, int T_hi, int c,
                                             const bf16x8 (&qf)[2][3], const int (&tok)[2], const int (&tokl)[2], f32x4 (&O)[2][6], float (&m)[2], float (&ls)[2]) {
    static_assert((NBS == 3 && CH == 1) || NBS == 2, "wait counts below");
    const int tid = tid_fresh(), lane = tid & 63, c16 = lane & 15, hh = lane >> 4, wid = __builtin_amdgcn_readfirstlane(tid >> 6);
    float rl[2] = {0.f, 0.f};
    if (!IMP) {
#pragma unroll
        for (int q = 0; q < 2; ++q) { m[q] = -1e20f; ls[q] = 0.f;
#pragma unroll
            for (int dt = 0; dt < 6; ++dt) O[q][dt] = (f32x4){0.f, 0.f, 0.f, 0.f}; }
    } else { rl[0] = 1.0f / fmaxf(ls[0], 1e-30f); rl[1] = 1.0f / fmaxf(ls[1], 1e-30f); }
    dma_plan<MODE == MODE_CMP>(lds, kstride, vstride, wid, lane, tid);
#pragma unroll
    for (int d = 0; d < NBS - 1; ++d)
#pragma unroll
        for (int t = 0; t < CH; ++t) { const int Tn = T_lo + d * CH + t; dma_issue<MODE == MODE_CMP>(lds, d * CH + t, Tn <= T_hi ? Tn : T_hi, kb, kstride, vb, wid, tid); }
    int sb = 0;
    for (int Ts = T_lo; Ts <= T_hi; Ts += CH) {
        if (NBS == 3) asm volatile("s_waitcnt vmcnt(3)" ::: "memory"); else asm volatile("s_waitcnt vmcnt(0)" ::: "memory");
        __builtin_amdgcn_s_barrier();
        asm volatile("" ::: "memory");
        { const int nb = (sb == 0) ? NBS - 1 : sb - 1;
#pragma unroll
          for (int t = 0; t < CH; ++t) { const int Tn = Ts + (NBS - 1) * CH + t; dma_issue<MODE == MODE_CMP>(lds, nb * CH + t, Tn <= T_hi ? Tn : T_hi, kb, kstride, vb, wid, tid); } }
#pragma unroll 1
        for (int t = 0; t < CH; ++t) { const int T = Ts + t; if (T > T_hi) break;
            LAS const unsigned char* ks = lds + (sb * CH + t) * A_BUF; LAS const unsigned char* vs = ks + A_KSZ;
            if (IMP) imp_compute(ks, T, qf, tok, tokl, m, rl, (LAS float*)(lds + A_IMP), c16, hh);
            else {
                bool selq[2] = {true, true};
                bool masked;
                if (MODE == MODE_WIN) masked = (T == c) || (T == c - 8);
                else if (MODE == MODE_CMP) masked = (1024 * T + 1039 > 64 * c);
                else masked = (T == c);
                if (MODE == MODE_SLC) {
                    LAS const unsigned* selw = (LAS const unsigned*)(lds + A_SEL);
                    int qm = 0;
#pragma unroll
                    for (int q = 0; q < 2; ++q) { selq[q] = (selw[tokl[q] * 8 + (T >> 5)] >> (T & 31)) & 1u; if (__builtin_amdgcn_ballot_w64(selq[q]) != 0ull) qm |= 1 << q; }
                    if (qm == 3) tile_compute<MODE, 3>(ks, vs, T, masked, qf, tok, selq, O, m, ls, c16, hh);
                    else if (qm == 1) tile_compute<MODE, 1>(ks, vs, T, masked, qf, tok, selq, O, m, ls, c16, hh);
                    else if (qm == 2) tile_compute<MODE, 2>(ks, vs, T, masked, qf, tok, selq, O, m, ls, c16, hh);
                } else tile_compute<MODE, 3>(ks, vs, T, masked, qf, tok, selq, O, m, ls, c16, hh);
            } }
        sb = (sb + 1 >= NBS) ? 0 : sb + 1;
    }
    asm volatile("s_waitcnt vmcnt(0) lgkmcnt(0)" ::: "memory");
    __builtin_amdgcn_s_barrier();
    asm volatile("" ::: "memory");
}

__device__ void attn_item(LAS unsigned char* lds, int b, int g, int c, const bf16_t* proj, const bf16_t* vtb, const bf16_t* kcmp, const bf16_t* vcmpT, const float* bgate, bf16_t* concat) {
    const int tid = tid_fresh(), wid = tid >> 6, lane = tid & 63, c16 = lane & 15, hh = lane >> 4;
    const int bg = b * 2 + g, t0 = 64 * c;
    int tok[2], tokl[2]; bf16x8 qf[2][3];
    const int head8 = g * 4 + (c16 & 3);
#pragma unroll
    for (int q = 0; q < 2; ++q) { tokl[q] = 8 * wid + 4 * q + (c16 >> 2); tok[q] = t0 + tokl[q];
        const bf16_t* rowp = proj + (size_t)(b * SEQ + tok[q]) * NPROJ;
#pragma unroll
        for (int k3 = 0; k3 < 3; ++k3) qf[q][k3] = *(const bf16x8*)(rowp + C_Q + head8 * 96 + 32 * k3 + 8 * hh); }
    f32x4 O[2][6]; float m[2], ls[2];
    { LAS float* imp = (LAS float*)(lds + A_IMP); for (int i = tid; i < 64 * A_IMPW; i += 512) imp[i] = 0.f; }
    asm volatile("s_waitcnt vmcnt(0)" ::: "memory");
#define FINALIZE(br, FIRST) do { _Pragma("unroll") for (int q = 0; q < 2; ++q) { float l = xr32_sum(xr16_sum(ls[q])); ls[q] = l; \
        int tq_ = tok[q]; asm volatile("" : "+v"(tq_)); const bf16_t* rowp = proj + (size_t)(b * SEQ + tq_) * NPROJ; const float gx = bf2f(rowp[C_G + head8 * 3 + br]) + bgate[head8 * 3 + br]; \
        const float inv = (1.0f / (1.0f + __expf(-gx))) / fmaxf(l, 1e-30f); \
        bf16_t* op = concat + (size_t)(b * SEQ + tq_) * DM + 256 + head8 * 96 + 4 * hh; \
        _Pragma("unroll") for (int dt = 0; dt < 6; ++dt) { u32x2 w = {0u, 0u}; if (!(FIRST)) w = *(const u32x2*)(op + 16 * dt); const f32x4 v = O[q][dt] * inv; \
            const f32v2_t w01 = unpk_f16(w.x), w23 = unpk_f16(w.y); const float a0 = w01[0] + v[0], a1 = w01[1] + v[1], a2 = w23[0] + v[2], a3 = w23[1] + v[3]; \
            *(u32x2*)(op + 16 * dt) = (u32x2){cvt_pk_f16(a0, a1), cvt_pk_f16(a2, a3)}; } } \
        asm volatile("s_waitcnt vmcnt(0)" ::: "memory"); } while (0)
    { const int T_lo = (c - 8) > 0 ? (c - 8) : 0;
      flash_branch<MODE_WIN, false, 3, 1>(lds, proj + (size_t)b * SEQ * NPROJ + C_KW + g * 96, NPROJ, vtb + (size_t)(192 + g * 96) * MTOK + (size_t)b * SEQ, MTOK, T_lo, c, c, qf, tok, tokl, O, m, ls);
      FINALIZE(2, true); }
    const int Tc = (4 * c + 2) >> 6;
    const bf16_t* kcb = kcmp + (size_t)bg * 1024 * 96; const bf16_t* vcb = vcmpT + (size_t)bg * 96 * 1024;
    flash_branch<MODE_CMP, false, 3, 1>(lds, kcb, 96, vcb, 1024, 0, Tc, c, qf, tok, tokl, O, m, ls);
    FINALIZE(0, false);
    if (c >= 16) flash_branch<MODE_CMP, true, 3, 1>(lds, kcb, 96, vcb, 1024, 0, Tc, c, qf, tok, tokl, O, m, ls);
    { LAS unsigned* selw = (LAS unsigned*)(lds + A_SEL); LAS const float* imp = (LAS const float*)(lds + A_IMP);
#pragma unroll 2
      for (int i = 0; i < 8; ++i) { const int tl = 8 * wid + i;
          if (c <= 15) { if (lane < 8) selw[tl * 8 + lane] = (lane == 0) ? ((2u << c) - 1u) : 0u; }
          else {
              unsigned key[4]; unsigned picked = 0;
#pragma unroll
              for (int q4 = 0; q4 < 4; ++q4) { const int j = lane + 64 * q4; const bool ok = (j >= 1) && (j <= c - 2);
                  key[q4] = ok ? ((__float_as_uint(imp[tl * A_IMPW + j]) & 0xFFFFFF00u) | (unsigned)(255 - j)) : 0u; }
#pragma unroll 1
              for (int rnd = 0; rnd < 13; ++rnd) {
                  unsigned best = max(max(key[0], key[1]), max(key[2], key[3]));
                  { const auto a = __builtin_amdgcn_permlane32_swap(best, best, false, false); best = max(a[0], a[1]); }
                  { const auto a = __builtin_amdgcn_permlane16_swap(best, best, false, false); best = max(a[0], a[1]); }
                  best = max(best, dpp_u<DPP_XOR1>(best)); best = max(best, dpp_u<DPP_XOR2>(best)); best = max(best, dpp_u<DPP_ROR4>(best)); best = max(best, dpp_u<DPP_ROR8>(best));
#pragma unroll
                  for (int q4 = 0; q4 < 4; ++q4) if (key[q4] == best && best != 0u) { key[q4] = 0u; picked |= 1u << q4; }
              }
#pragma unroll
              for (int q4 = 0; q4 < 4; ++q4) { const int j = lane + 64 * q4; const bool on = ((picked >> q4) & 1u) || j == 0 || j == c - 1 || j == c;
                  const unsigned long long bal = __builtin_amdgcn_ballot_w64(on);
                  if (lane == 0) { selw[tl * 8 + 2 * q4] = (unsigned)bal; selw[tl * 8 + 2 * q4 + 1] = (unsigned)(bal >> 32); } }
          } } }
    __syncthreads();
    flash_branch<MODE_SLC, false, 2, SLC_CH>(lds, proj + (size_t)b * SEQ * NPROJ + C_KS + g * 96, NPROJ, vtb + (size_t)(g * 96) * MTOK + (size_t)b * SEQ, MTOK, 0, c, c, qf, tok, tokl, O, m, ls);
    FINALIZE(1, false);
#undef FINALIZE
}

__device__ __forceinline__ void gemm_ln(LAS unsigned char* lds, unsigned char* ws, int gid, const bf16_t* A, int K, const bf16_t* Bt, float* xf  , bf16_t* xb,
                                        const float* gam, const float* bet, float alpha, float beta, int G, int bx) {
    for (int half = 0; half < 2; ++half) {
        const size_t r0 = (size_t)half * (MTOK / 2);
        pg8::Gemm g{A + r0 * K, Bt, MTOK / 2, DM, K}; pg8::StaticOrder S; S.init(MTOK / 2, DM, G, bx);
        pg8::PanelStats st{(unsigned*)(ws + WS_XCH + (size_t)(gid * 2 + half) * SZ_XCH), (unsigned*)(ws + WS_CNT + (size_t)(gid * 2 + half) * 64 * 256), 1e-5f};
        pg8::EpiLnAff E{xb + r0 * DM, xf ? xf + r0 * DM : nullptr, xb + r0 * DM, gam, bet, alpha, beta, st};
        pg8::gemm_phase(lds, g, S, E);
    }
}

__global__ void __launch_bounds__(512, 2) hymba_fwd(Params p) {
    extern __shared__ __attribute__((aligned(16))) unsigned char shm[];
    LAS unsigned char* lds = (LAS unsigned char*)shm;
    cg::grid_group grid = cg::this_grid();
    unsigned char* ws = p.ws;
    const int G = gridDim.x, bx = blockIdx.x;
    bf16_t* xb = (bf16_t*)(ws + WS_XB); bf16_t* Hb = (bf16_t*)(ws + WS_H); bf16_t* proj = (bf16_t*)(ws + WS_PROJ); bf16_t* vtb = (bf16_t*)(ws + WS_VTB);
    bf16_t* concat = (bf16_t*)(ws + WS_CONCAT); bf16_t* kcmp = (bf16_t*)(ws + WS_KCMP); bf16_t* vcmpT = (bf16_t*)(ws + WS_VCMPT);
    float* xf = p.out;

    if (threadIdx.x < 4) ((LAS unsigned*)(lds + LDS_BYTES - 16))[threadIdx.x] = 0u;
    __syncthreads();
    const XcdBarrier xbar = xcd_barrier_post((unsigned*)(ws + WS_BAR), (volatile LAS unsigned*)(lds + LDS_BYTES - 16));
    p0_phase(p, lds);
    grid.sync();

    for (int l = 0; l < 2; ++l) {
        for (int f = 0; f < 2; ++f) {
            if (f == 1) {
                { pg8::Gemm g{xb, (const bf16_t*)(ws + WS_WIN + (size_t)l * SZ_WIN), MTOK, NPROJ, DM}; pg8::StaticOrder S; S.init(MTOK, NPROJ, G, bx);
                  pg8::EpiBf16 E{proj, NPROJ}; pg8::gemm_phase<pg8::EpiBf16, pg8::StaticOrder, true>(lds, g, S, E); }
                { pg8::Gemm g{(const bf16_t*)(ws + WS_WVT + (size_t)l * SZ_WVT), xb, NVT, MTOK, DM}; pg8::StaticOrder S; S.init(NVT, MTOK, G, bx);
                  pg8::EpiBf16 E{vtb, MTOK}; pg8::gemm_phase<pg8::EpiBf16, pg8::StaticOrder, true>(lds, g, S, E); }
                xcd_barrier(xbar);
                for (int it = bx; it < 256; it += G) compress_item(lds, it, proj, ws, l, kcmp, vcmpT);
                for (int it = bx; it < 512; it += G) pool_item(lds, it, proj, p.in[I_POOLW] + (size_t)l * 4 * 64 * 64, p.in[I_POOLS] + (size_t)l * 256, concat);
                xcd_barrier(xbar);
                for (int r = 0; r * G < 1024; ++r) { const int k = (r & 1) ? ((r + 1) * G - 1 - bx) : (r * G + bx); if (k >= 1024) continue;
                    const int c = 255 - (k >> 2), bg = k & 3; attn_item(lds, bg >> 1, bg & 1, c, proj, vtb, kcmp, vcmpT, p.in[I_BGATE] + (size_t)l * 24, concat); }
                xcd_barrier(xbar);
                gemm_ln(lds, ws, l * 3 + 1, concat, DM, (const bf16_t*)(ws + WS_WOUT + (size_t)l * SZ_WOUT), nullptr, xb, p.in[I_LN2G] + (size_t)l * DM, p.in[I_LN2B] + (size_t)l * DM, ALPHA, 1.0f, G, bx);
                xcd_barrier(xbar);
            }
            { pg8::Gemm g{xb, (const bf16_t*)(ws + WS_WGU + (size_t)(l * 2 + f) * SZ_WGU), MTOK, 2 * DFF, DM}; pg8::StaticOrder S; S.init(MTOK, 2 * DFF, G, bx);
              pg8::EpiSwiglu E{Hb, DFF}; pg8::gemm_phase<pg8::EpiSwiglu, pg8::StaticOrder, true>(lds, g, S, E); }
            xcd_barrier(xbar);
            gemm_ln(lds, ws, l * 3 + (f ? 2 : 0), Hb, DFF, (const bf16_t*)(ws + WS_WDN + (size_t)(l * 2 + f) * SZ_WDN), (l == 1 && f == 1) ? xf : nullptr, xb,
                    p.in[f ? I_LN3G : I_LN1G] + (size_t)l * DM, p.in[f ? I_LN3B : I_LN1B] + (size_t)l * DM, ALPHA, 0.5f, G, bx);
            xcd_barrier(xbar);
        }
    }
}

extern "C" void kernel_launch(void* const* d_in, const int* in_sizes, int n_in, void* d_out, int out_size, void* d_ws, size_t ws_size, hipStream_t stream) {
    static int grid_blocks = 0;
    if (!grid_blocks) {
        if (n_in != 24 || ws_size < WS_END2) { fprintf(stderr, "kernel_launch: unexpected n_in %d / ws %zu (need %zu)\n", n_in, ws_size, (size_t)WS_END2); grid_blocks = -1; return; }
        int dev = 0, cus = 0, per_cu = 0;
        hipGetDevice(&dev);
        hipDeviceGetAttribute(&cus, hipDeviceAttributeMultiprocessorCount, dev);
        if (hipFuncSetAttribute((const void*)hymba_fwd, hipFuncAttributeMaxDynamicSharedMemorySize, LDS_BYTES) != hipSuccess) { fprintf(stderr, "kernel_launch: hipFuncSetAttribute failed\n"); grid_blocks = -1; return; }
        hipOccupancyMaxActiveBlocksPerMultiprocessor(&per_cu, (const void*)hymba_fwd, 512, LDS_BYTES);
        if (per_cu < 1) per_cu = 1;
        if (cus < 256 || per_cu < 1) fprintf(stderr, "kernel_launch: note: %d CUs, occupancy query %d; this kernel is built for 256 co-resident workgroups (one per CU)\n", cus, per_cu);
        grid_blocks = 256;
        (void)hipGetLastError();
    }
    if (grid_blocks < 0) return;
    if (hipMemsetAsync((unsigned char*)d_ws + WS_CNT, 0, (size_t)12 * 64 * 256 + 16384, stream) != hipSuccess) { fprintf(stderr, "kernel_launch: hipMemsetAsync failed\n"); return; }
    Params p{};
    for (int i = 0; i < 24; ++i) p.in[i] = (const float*)d_in[i];
    p.out = (float*)d_out; p.ws = (unsigned char*)d_ws;
    void* args[] = {&p};
    hipError_t e = hipLaunchCooperativeKernel((const void*)hymba_fwd, dim3(grid_blocks), dim3(512), args, LDS_BYTES, stream);
    if (e != hipSuccess) fprintf(stderr, "cooperative launch failed: %s (grid %d)\n", hipGetErrorString(e), grid_blocks);
}
```

```cpp
#include <hip/hip_runtime.h>
#include <hip/hip_cooperative_groups.h>
#include <cstdio>
namespace cg = cooperative_groups;

#define LAS __attribute__((address_space(3)))
typedef unsigned short bf16_t;
typedef short bf16x8 __attribute__((ext_vector_type(8)));
typedef float f32x4 __attribute__((ext_vector_type(4)));
typedef unsigned u32x4 __attribute__((ext_vector_type(4)));
typedef unsigned u32x2 __attribute__((ext_vector_type(2)));

constexpr int SEQ = 16384, MTOK = 32768, DM = 1024, DFF = 2816, NPROJ = 2048, NVT = 512;
constexpr int C_Q = 256, C_KC = 1024, C_VC = 1216, C_KS = 1408, C_KW = 1600, C_G = 1792;
constexpr float ALPHA = 1.41421356237309515f;
constexpr int LDS_BYTES = 160 * 1024;

constexpr size_t SZ_WGU = (size_t)5632 * 1024 * 2, SZ_WDN = (size_t)1024 * 2816 * 2, SZ_WIN = (size_t)NPROJ * 1024 * 2, SZ_WVT = (size_t)NVT * 1024 * 2,
                 SZ_WOUT = (size_t)1024 * 1024 * 2, SZ_WC1 = (size_t)96 * 3072 * 2, SZ_WC2 = (size_t)96 * 96 * 2, SZ_POSW = 512;
constexpr size_t WS_WGU = 0, WS_WDN = WS_WGU + 4 * SZ_WGU, WS_WIN = WS_WDN + 4 * SZ_WDN, WS_WVT = WS_WIN + 2 * SZ_WIN, WS_WOUT = WS_WVT + 2 * SZ_WVT,
                 WS_WC1 = WS_WOUT + 2 * SZ_WOUT, WS_WC2 = WS_WC1 + 4 * SZ_WC1, WS_POSW = WS_WC2 + 4 * SZ_WC2, WS_XB = WS_POSW + 4 * SZ_POSW,
                 WS_KCMP = WS_XB + (size_t)MTOK * DM * 2, WS_VCMPT = WS_KCMP + (size_t)4 * 1024 * 96 * 2, WS_BIG = WS_VCMPT + (size_t)4 * 96 * 1024 * 2,
                 WS_H = WS_BIG, WS_PROJ = WS_BIG, WS_VTB = WS_PROJ + (size_t)MTOK * NPROJ * 2, WS_CONCAT = WS_VTB + (size_t)NVT * MTOK * 2,
                 WS_END = WS_CONCAT + (size_t)MTOK * DM * 2;
constexpr size_t WS_XCH = WS_END, SZ_XCH = (size_t)64 * 256 * 4 * 8, WS_CNT = WS_XCH + 12 * SZ_XCH, WS_BAR = WS_CNT + (size_t)12 * 64 * 256, WS_POSP = WS_BAR + 16384, WS_END2 = WS_POSP + (size_t)4 * 32 * 96 * 4;
static_assert(WS_END >= WS_H + (size_t)MTOK * DFF * 2, "union");
static_assert(WS_END2 + 256 <= (size_t)512 * 1024 * 1024, "ws");
static_assert(WS_XB % 256 == 0 && WS_BIG % 256 == 0, "align");

__device__ __forceinline__ int tid_fresh() { int t = threadIdx.x; asm volatile("" : "+v"(t)); return t; }
typedef __bf16 bf16v2_t __attribute__((ext_vector_type(2)));
typedef float f32v2_t __attribute__((ext_vector_type(2)));
__device__ __forceinline__ unsigned cvt_pk_bf16(float lo, float hi) { const f32v2_t v = {lo, hi}; return __builtin_bit_cast(unsigned, __builtin_convertvector(v, bf16v2_t)); }
typedef _Float16 f16v2_t __attribute__((ext_vector_type(2)));
typedef _Float16 f16x8 __attribute__((ext_vector_type(8)));
__device__ __forceinline__ unsigned cvt_pk_f16(float lo, float hi) { const f32v2_t v = {lo, hi}; return __builtin_bit_cast(unsigned, __builtin_convertvector(v, f16v2_t)); }
__device__ __forceinline__ unsigned cvt_pk_f16_b(float lo, float hi) { const unsigned b = cvt_pk_bf16(lo, hi); return cvt_pk_f16(__uint_as_float(b << 16), __uint_as_float(b & 0xffff0000u)); }
__device__ __forceinline__ f32v2_t unpk_f16(unsigned u) { return __builtin_convertvector(__builtin_bit_cast(f16v2_t, u), f32v2_t); }
__device__ __forceinline__ bf16_t f2h(float f) { return (bf16_t)(cvt_pk_f16(f, 0.f) & 0xffffu); }
__device__ __forceinline__ bf16_t f2bf(float f) { return (bf16_t)(cvt_pk_bf16(f, 0.f) & 0xffffu); }
__device__ __forceinline__ float bf2f(bf16_t b) { return __uint_as_float(((unsigned)b) << 16); }

__device__ __forceinline__ float xr16_max(float x) { const auto r = __builtin_amdgcn_permlane16_swap(__float_as_uint(x), __float_as_uint(x), false, false); return fmaxf(__uint_as_float(r[0]), __uint_as_float(r[1])); }
__device__ __forceinline__ float xr32_max(float x) { const auto r = __builtin_amdgcn_permlane32_swap(__float_as_uint(x), __float_as_uint(x), false, false); return fmaxf(__uint_as_float(r[0]), __uint_as_float(r[1])); }
__device__ __forceinline__ float xr16_sum(float x) { const auto r = __builtin_amdgcn_permlane16_swap(__float_as_uint(x), __float_as_uint(x), false, false); return __uint_as_float(r[0]) + __uint_as_float(r[1]); }
__device__ __forceinline__ float xr32_sum(float x) { const auto r = __builtin_amdgcn_permlane32_swap(__float_as_uint(x), __float_as_uint(x), false, false); return __uint_as_float(r[0]) + __uint_as_float(r[1]); }
template <int CTRL> __device__ __forceinline__ unsigned dpp_u(unsigned x) { return (unsigned)__builtin_amdgcn_update_dpp((int)x, (int)x, CTRL, 0xF, 0xF, false); }
template <int CTRL> __device__ __forceinline__ float dpp_f(float x) { return __uint_as_float(dpp_u<CTRL>(__float_as_uint(x))); }
constexpr int DPP_XOR1 = 0xB1, DPP_XOR2 = 0x4E, DPP_ROR4 = 0x124, DPP_ROR8 = 0x128;
__device__ __forceinline__ unsigned long long u64max(unsigned long long a, unsigned long long b) { return a > b ? a : b; }
__device__ __forceinline__ unsigned long long wave_max_u64(unsigned long long v) {
    unsigned lo = (unsigned)v, hi = (unsigned)(v >> 32);
    { const auto a = __builtin_amdgcn_permlane32_swap(lo, lo, false, false); const auto b = __builtin_amdgcn_permlane32_swap(hi, hi, false, false);
      v = u64max(((unsigned long long)b[0] << 32) | a[0], ((unsigned long long)b[1] << 32) | a[1]); lo = (unsigned)v; hi = (unsigned)(v >> 32); }
    { const auto a = __builtin_amdgcn_permlane16_swap(lo, lo, false, false); const auto b = __builtin_amdgcn_permlane16_swap(hi, hi, false, false);
      v = u64max(((unsigned long long)b[0] << 32) | a[0], ((unsigned long long)b[1] << 32) | a[1]); lo = (unsigned)v; hi = (unsigned)(v >> 32); }
    v = u64max(v, ((unsigned long long)dpp_u<DPP_XOR1>(hi) << 32) | dpp_u<DPP_XOR1>(lo)); lo = (unsigned)v; hi = (unsigned)(v >> 32);
    v = u64max(v, ((unsigned long long)dpp_u<DPP_XOR2>(hi) << 32) | dpp_u<DPP_XOR2>(lo)); lo = (unsigned)v; hi = (unsigned)(v >> 32);
    v = u64max(v, ((unsigned long long)dpp_u<DPP_ROR4>(hi) << 32) | dpp_u<DPP_ROR4>(lo)); lo = (unsigned)v; hi = (unsigned)(v >> 32);
    v = u64max(v, ((unsigned long long)dpp_u<DPP_ROR8>(hi) << 32) | dpp_u<DPP_ROR8>(lo));
    return v;
}

namespace pg8 {
constexpr int BM = 256, BK = 64, HALF = 128, HTB = HALF * BK * 2, STAGE_BYTES = 8 * HTB, NXCD = 8, WGM = 8;
__host__ __device__ __forceinline__ int lds_byte(int r, int c) { const int st = (r >> 4) * 2 + (c >> 5), rr = r & 15, cc = c & 31, ob = rr * 64 + cc * 2; return st * 1024 + (ob ^ (((ob >> 9) & 1) << 5)); }
__host__ __device__ __forceinline__ void stage_rc(int b, int& R, int& C) { const int st = b / 1024, sb = b % 1024, swz = sb ^ (((sb >> 9) & 1) << 5); R = (st >> 1) * 16 + swz / 64; C = (st & 1) * 32 + (swz % 64) / 2; }
__host__ __device__ __forceinline__ int perm32(int rho) { const int n = rho >> 4, i = rho & 15; return 8 * (i >> 2) + 4 * n + (i & 3); }
struct Unit { int pm, pn; };
struct Gemm { const bf16_t* A; const bf16_t* Bt; int M, N, K; };
struct StaticOrder {
    int nM, nN, nwg, G, c;
    __host__ __device__ void init(int M, int N, int G_, int c_) { nM = M / BM; nN = N / BM; nwg = nM * nN; G = G_; c = c_; }
    __host__ __device__ bool next(int i, Unit& u) const {
        const long L = (long)i * G + c; if (L >= nwg) return false;
        int wgid = (int)L; { const int q = nwg / NXCD, r = nwg % NXCD, xcd = wgid % NXCD, off = wgid / NXCD; wgid = (xcd < r ? xcd * (q + 1) : r * (q + 1) + (xcd - r) * q) + off; }
        const int nig = WGM * nN, gid = wgid / nig, fm = gid * WGM, gsz = (nM - fm) < WGM ? (nM - fm) : WGM;
        u.pm = fm + ((wgid % nig) % gsz); u.pn = (wgid % nig) / gsz; return true;
    }
    __device__ __forceinline__ void a_ready(const Unit&) const {}
    __device__ __forceinline__ void done(const Unit&) const {}
};

struct EpiBf16 {
    static constexpr bool PERM = true, AFTER_DRAIN = false;
    bf16_t* O; int ldc;
    __device__ __forceinline__ void operator()(const f32x4 (&acc)[2][2][4][2], const Unit& u, int wr, int wc, int fr, int fq) const {
        const int row0 = u.pm * BM + wr * 64 + fr, col0 = u.pn * BM + wc * 32 + 8 * fq;
#pragma unroll
        for (int ai = 0; ai < 2; ++ai)
#pragma unroll
            for (int m = 0; m < 4; ++m) { bf16_t* rowp = O + (size_t)(row0 + ai * HALF + m * 16) * ldc + col0;
#pragma unroll
                for (int bj = 0; bj < 2; ++bj) { const f32x4 v0 = acc[ai][bj][m][0], v1 = acc[ai][bj][m][1];
                    u32x4 w; w.x = cvt_pk_bf16(v0[0], v0[1]); w.y = cvt_pk_bf16(v0[2], v0[3]); w.z = cvt_pk_bf16(v1[0], v1[1]); w.w = cvt_pk_bf16(v1[2], v1[3]);
                    *(u32x4*)(rowp + bj * HALF) = w; } }
    }
};
struct EpiSwiglu {
    static constexpr bool PERM = true, AFTER_DRAIN = false;
    bf16_t* H; int ldh;
    __device__ __forceinline__ void operator()(const f32x4 (&acc)[2][2][4][2], const Unit& u, int wr, int wc, int fr, int fq) const {
        const int row0 = u.pm * BM + wr * 64 + fr, col0 = u.pn * HALF + wc * 32 + 8 * fq;
#pragma unroll
        for (int ai = 0; ai < 2; ++ai)
#pragma unroll
            for (int m = 0; m < 4; ++m) { bf16_t* rowp = H + (size_t)(row0 + ai * HALF + m * 16) * ldh + col0;
                float h[8];
#pragma unroll
                for (int n = 0; n < 2; ++n)
#pragma unroll
                    for (int j = 0; j < 4; ++j) { const float g = acc[ai][0][m][n][j], up = acc[ai][1][m][n][j]; h[n * 4 + j] = g * up * __builtin_amdgcn_rcpf(1.0f + __builtin_amdgcn_exp2f(-1.4426950408889634f * g)); }
                u32x4 w; w.x = cvt_pk_f16_b(h[0], h[1]); w.y = cvt_pk_f16_b(h[2], h[3]); w.z = cvt_pk_f16_b(h[4], h[5]); w.w = cvt_pk_f16_b(h[6], h[7]);
                *(u32x4*)rowp = w; }
    }
};
struct PanelStats {
    unsigned* xbuf;
    unsigned* cnt;
    float eps;
    __device__ __forceinline__ void run(const f32x4 (&v)[2][2][4][2], const Unit& u, int wr, int wc, int fr, int fq, LAS unsigned char* lds, int wid, int lane) const {
        typedef float f32x2v __attribute__((ext_vector_type(2)));
        LAS f32x2v* P = (LAS f32x2v*)lds;
        LAS f32x2v* S = (LAS f32x2v*)(lds + 8192);
#pragma unroll
        for (int ai = 0; ai < 2; ++ai)
#pragma unroll
            for (int m = 0; m < 4; ++m) {
                float s = 0.f;
#pragma unroll
                for (int bj = 0; bj < 2; ++bj)
#pragma unroll
                    for (int n = 0; n < 2; ++n) { const f32x4 x = v[ai][bj][m][n]; s += (x[0] + x[1]) + (x[2] + x[3]); }
                s = xr32_sum(xr16_sum(s));
                const float mw = s * (1.0f / 64.0f); float q = 0.f;
#pragma unroll
                for (int bj = 0; bj < 2; ++bj)
#pragma unroll
                    for (int n = 0; n < 2; ++n) { const f32x4 d = v[ai][bj][m][n] - mw; q += (d[0] * d[0] + d[1] * d[1]) + (d[2] * d[2] + d[3] * d[3]); }
                q = xr32_sum(xr16_sum(q));
                if (fq == 0) P[(ai * HALF + wr * 64 + m * 16 + fr) * 4 + wc] = (f32x2v){mw, q};
            }
        asm volatile("s_waitcnt lgkmcnt(0)" ::: "memory"); __builtin_amdgcn_s_barrier(); asm volatile("" ::: "memory");
        const int row = wid * 32 + (lane & 31);
        if (lane < 32) {
            const f32x2v a = P[row * 4 + 0], b = P[row * 4 + 1], c = P[row * 4 + 2], d = P[row * 4 + 3];
            const float mt = (a.x + b.x + c.x + d.x) * 0.25f;
            const float da = a.x - mt, db = b.x - mt, dc = c.x - mt, dd = d.x - mt;
            const float m2 = (a.y + b.y) + (c.y + d.y) + 64.0f * ((da * da + db * db) + (dc * dc + dd * dd));
            unsigned long long* slot = (unsigned long long*)xbuf + ((size_t)(u.pm * BM + row) * 4 + u.pn);
            __hip_atomic_store(slot, ((unsigned long long)__float_as_uint(m2) << 32) | __float_as_uint(mt), __ATOMIC_RELAXED, __HIP_MEMORY_SCOPE_AGENT);
        }
        asm volatile("s_waitcnt vmcnt(0)" ::: "memory");
        if (lane == 0) __hip_atomic_fetch_add(cnt + 64 * u.pm, 1u, __ATOMIC_RELAXED, __HIP_MEMORY_SCOPE_AGENT);
        if (wid == 0) {
            for (unsigned it = 0; it < 200000000u; ++it) {
                if ((unsigned)__builtin_amdgcn_readfirstlane(__hip_atomic_load(cnt + 64 * u.pm, __ATOMIC_RELAXED, __HIP_MEMORY_SCOPE_AGENT)) >= 32u) break;
                __builtin_amdgcn_s_sleep(2);
            }
            __builtin_amdgcn_fence(__ATOMIC_ACQUIRE, "agent");
        }
        asm volatile("s_waitcnt vmcnt(0) lgkmcnt(0)" ::: "memory"); __builtin_amdgcn_s_barrier(); asm volatile("" ::: "memory");
        if (lane < 32) {
            const unsigned long long* slot = (const unsigned long long*)xbuf + (size_t)(u.pm * BM + row) * 4; float mt[4], m2[4]; float ms = 0.f;
#pragma unroll
            for (int t = 0; t < 4; ++t) { const unsigned long long w = __hip_atomic_load(slot + t, __ATOMIC_RELAXED, __HIP_MEMORY_SCOPE_AGENT); mt[t] = __uint_as_float((unsigned)w); m2[t] = __uint_as_float((unsigned)(w >> 32)); ms += mt[t]; }
            const float mean = ms * 0.25f; float q = 0.f;
#pragma unroll
            for (int t = 0; t < 4; ++t) { const float dm = mt[t] - mean; q += m2[t] + 256.0f * dm * dm; }
            S[row] = (f32x2v){mean, 1.0f / sqrtf(q * (1.0f / 1024.0f) + eps)};
        }
        asm volatile("s_waitcnt lgkmcnt(0)" ::: "memory"); __builtin_amdgcn_s_barrier(); asm volatile("" ::: "memory");
    }
};
struct EpiLnAff {
    static constexpr bool PERM = false, AFTER_DRAIN = true;
    const bf16_t* base; float* out  ; bf16_t* xb; const float* gam; const float* bet; float alpha, beta; PanelStats st;
    __device__ __forceinline__ void operator()(const f32x4 (&)[2][2][4][2], const Unit&, int, int, int, int) const {}
    __device__ __forceinline__ void fused(f32x4 (&acc)[2][2][4][2], const Unit& u, int wr, int wc, int fr, int fq, LAS unsigned char* lds, int wid, int lane) const {
        typedef float f32x2v __attribute__((ext_vector_type(2)));
        const LAS f32x2v* S = (const LAS f32x2v*)(lds + 8192);
        const int col0 = u.pn * BM + wc * 32 + 4 * fq;
        { const int t = wid * 64 + lane;
#pragma unroll
          for (int hf = 0; hf < 2; ++hf) { u32x4 v[8];
#pragma unroll
            for (int i = 0; i < 8; ++i) { const int id = t + 512 * (8 * hf + i), row = id >> 5, ch = id & 31; v[i] = *(const u32x4*)(base + (size_t)(u.pm * BM + row) * 1024 + u.pn * BM + ch * 8); }
#pragma unroll
            for (int i = 0; i < 8; ++i) { const int id = t + 512 * (8 * hf + i), row = id >> 5, ch = id & 31; *(LAS u32x4*)(lds + 16384 + row * 528 + ch * 16) = v[i]; }
            asm volatile("" ::: "memory"); } }
        asm volatile("s_waitcnt lgkmcnt(0)" ::: "memory"); __builtin_amdgcn_s_barrier(); asm volatile("" ::: "memory");
#pragma unroll
        for (int ai = 0; ai < 2; ++ai)
#pragma unroll
            for (int m = 0; m < 4; ++m) { const int rr = ai * HALF + wr * 64 + m * 16 + fr;
#pragma unroll
                for (int bj = 0; bj < 2; ++bj)
#pragma unroll
                    for (int n = 0; n < 2; ++n) { const u32x2 bw = *(const LAS u32x2*)(lds + 16384 + rr * 528 + (wc * 32 + 4 * fq + bj * HALF + n * 16) * 2);
                        const f32v2_t b01 = unpk_f16(bw.x), b23 = unpk_f16(bw.y); const f32x4 bs = {b01[0], b01[1], b23[0], b23[1]};
                        acc[ai][bj][m][n] = bs * alpha + acc[ai][bj][m][n] * beta; }
                asm volatile("" : "+v"(acc[ai][0][m][0]), "+v"(acc[ai][0][m][1]), "+v"(acc[ai][1][m][0]), "+v"(acc[ai][1][m][1]));
                if (m & 1) asm volatile("" ::: "memory"); }
        st.run(acc, u, wr, wc, fr, fq, lds, wid, lane);
#pragma unroll
        for (int bj = 0; bj < 2; ++bj)
#pragma unroll
            for (int n = 0; n < 2; ++n) { const f32x4 gv = *(const f32x4*)(gam + col0 + bj * HALF + n * 16), bv = *(const f32x4*)(bet + col0 + bj * HALF + n * 16);
#pragma unroll
                for (int ai = 0; ai < 2; ++ai)
#pragma unroll
                    for (int m = 0; m < 4; ++m) { const int r = ai * HALF + wr * 64 + m * 16 + fr; const f32x2v sr = S[r]; const size_t off = (size_t)(u.pm * BM + r) * 1024 + col0;
                        const f32x4 y = (acc[ai][bj][m][n] - sr.x) * sr.y * gv + bv; if (out) *(f32x4*)(out + off + bj * HALF + n * 16) = y;
                        u32x2 w; w.x = cvt_pk_f16(y[0], y[1]); w.y = cvt_pk_f16(y[2], y[3]);
                        *(LAS u32x2*)(lds + 16384 + r * 528 + (wc * 32 + 4 * fq + bj * HALF + n * 16) * 2) = w; }
                asm volatile("" ::: "memory"); }
        asm volatile("s_waitcnt lgkmcnt(0)" ::: "memory"); __builtin_amdgcn_s_barrier(); asm volatile("" ::: "memory");
        { const int t = wid * 64 + lane;
#pragma unroll
          for (int i = 0; i < 16; ++i) { const int id = t + 512 * i, row = id >> 5, ch = id & 31;
              *(u32x4*)(xb + (size_t)(u.pm * BM + row) * 1024 + u.pn * BM + ch * 8) = *(const LAS u32x4*)(lds + 16384 + row * 528 + ch * 16); } }
        asm volatile("s_waitcnt lgkmcnt(0)" ::: "memory"); __builtin_amdgcn_s_barrier(); asm volatile("" ::: "memory");
    }
};

template <class Epi, class Sched, bool ALIGN_EPI = false>
__device__ __forceinline__ void gemm_phase(LAS unsigned char* lds, const Gemm g, const Sched& S, const Epi& E) {
    int tid_ = threadIdx.x; asm volatile("" : "+v"(tid_));
    const int tid = tid_, wid = __builtin_amdgcn_readfirstlane(tid >> 6), lane = tid & 63, wr = wid >> 2, wc = wid & 3, fr = lane & 15, fq = lane >> 4;
    const int K = g.K, nt = K / BK;
    unsigned voffA[2], voffB[2];
#pragma unroll
    for (int i = 0; i < 2; ++i) { int R, C; stage_rc(tid * 16 + i * 8192, R, C); const int Rb = Epi::PERM ? ((R & ~31) + perm32(R & 31)) : R;
        voffA[i] = (unsigned)(R * K + C) * 2u; voffB[i] = (unsigned)(Rb * K + C) * 2u; }
    const size_t kstep = (size_t)(BK * 2);
    const size_t hstep = (size_t)HALF * K * 2;
    const size_t tstep = 2 * hstep;
    const unsigned ldsw = (unsigned)wid * 1024u;
    const int aoff = lds_byte(wr * 64 + fr, fq * 8), boff = lds_byte(wc * 32 + fr, fq * 8);
#define PG8_SA(b, h) (((b) * 2 + (h)) * HTB)
#define PG8_SB(b, h) ((4 + (b) * 2 + (h)) * HTB)
#define PG8_STAGE(bufoff, gbase, voff) do { _Pragma("unroll") for (int _i = 0; _i < 2; ++_i) \
        __builtin_amdgcn_global_load_lds((const unsigned*)((const char*)(gbase) + (voff)[_i]), (LAS unsigned*)(lds + (bufoff) + ldsw + _i * 8192), 16, 0, 0); } while (0)
#define PG8_LDA(dst, b, h) do { _Pragma("unroll") for (int m = 0; m < 4; ++m) _Pragma("unroll") for (int k = 0; k < 2; ++k) dst[m][k] = *(const LAS bf16x8*)(lds + PG8_SA(b, h) + aoff + m * 2048 + k * 1024); } while (0)
#define PG8_LDB(dst, b, h) do { _Pragma("unroll") for (int n = 0; n < 2; ++n) _Pragma("unroll") for (int k = 0; k < 2; ++k) dst[n][k] = *(const LAS bf16x8*)(lds + PG8_SB(b, h) + boff + n * 2048 + k * 1024); } while (0)
#define PG8_MMA(ai, bj, At, Bt) do { __builtin_amdgcn_s_setprio(1); _Pragma("unroll") for (int m = 0; m < 4; ++m) _Pragma("unroll") for (int n = 0; n < 2; ++n) _Pragma("unroll") for (int k = 0; k < 2; ++k) \
        acc[ai][bj][m][n] = __builtin_amdgcn_mfma_f32_16x16x32_f16(__builtin_bit_cast(f16x8, Bt[n][k]), __builtin_bit_cast(f16x8, At[m][k]), acc[ai][bj][m][n], 0, 0, 0); __builtin_amdgcn_s_setprio(0); } while (0)
#define PG8_WAIT_V(n) asm volatile("s_waitcnt vmcnt(" #n ")" ::: "memory")
#define PG8_WAIT_L(n) asm volatile("s_waitcnt lgkmcnt(" #n ")" ::: "memory")
#define PG8_BAR __builtin_amdgcn_s_barrier()
#define PG8_SCHED __builtin_amdgcn_sched_barrier(0)
    Unit cur, nxt; int ui = 0;
    if (!S.next(0, cur)) return;
    f32x4 acc[2][2][4][2];
#pragma unroll
    for (int a = 0; a < 2; ++a)
#pragma unroll
        for (int b = 0; b < 2; ++b)
#pragma unroll
            for (int m = 0; m < 4; ++m)
#pragma unroll
                for (int n = 0; n < 2; ++n) acc[a][b][m][n] = (f32x4){0.f, 0.f, 0.f, 0.f};
    bf16x8 At[4][2], B0[2][2], B1[2][2];
    const char* cA = (const char*)g.A + (size_t)cur.pm * tstep; const char* cB = (const char*)g.Bt + (size_t)cur.pn * tstep;
    S.a_ready(cur);
    PG8_STAGE(PG8_SB(0, 0), cB, voffB); PG8_STAGE(PG8_SB(0, 1), cB + hstep, voffB); PG8_STAGE(PG8_SA(0, 0), cA, voffA); PG8_STAGE(PG8_SA(0, 1), cA + hstep, voffA);
    if (wr == 1) PG8_BAR;
    PG8_WAIT_V(2); PG8_BAR;
    PG8_STAGE(PG8_SB(1, 0), cB + kstep, voffB); PG8_STAGE(PG8_SA(1, 0), cA + kstep, voffA); PG8_STAGE(PG8_SB(1, 1), cB + hstep + kstep, voffB);
    PG8_WAIT_V(6); PG8_BAR;
    for (;;) {
        const bool has_next = S.next(ui + 1, nxt);
        const char* nA = has_next ? (const char*)g.A + (size_t)nxt.pm * tstep : cA; const char* nB = has_next ? (const char*)g.Bt + (size_t)nxt.pn * tstep : cB;
        for (int t = 0; t < nt; t += 2) {
            const bool last = (t == nt - 2);
            const char* a1 = cA + (size_t)(t + 1) * kstep;
            const char* a2 = last ? nA : cA + (size_t)(t + 2) * kstep; const char* b2 = last ? nB : cB + (size_t)(t + 2) * kstep;
            const char* a3 = a2 + kstep; const char* b3 = b2 + kstep;
            if (last && has_next) S.a_ready(nxt);
            PG8_LDB(B0, 0, 0); PG8_LDB(B1, 0, 1); PG8_SCHED; PG8_LDA(At, 0, 0); PG8_STAGE(PG8_SA(1, 1), a1 + hstep, voffA);
            PG8_WAIT_V(8); PG8_WAIT_L(0); PG8_BAR; PG8_MMA(0, 0, At, B0); PG8_MMA(0, 1, At, B1); PG8_BAR; PG8_SCHED;
            PG8_LDA(At, 0, 1); PG8_STAGE(PG8_SB(0, 0), b2, voffB); PG8_STAGE(PG8_SB(0, 1), b2 + hstep, voffB); PG8_STAGE(PG8_SA(0, 0), a2, voffA);
            PG8_WAIT_V(8); PG8_WAIT_L(0); PG8_BAR; PG8_MMA(1, 0, At, B0); PG8_MMA(1, 1, At, B1); PG8_BAR; PG8_SCHED;
            PG8_LDB(B0, 1, 0); PG8_LDB(B1, 1, 1); PG8_SCHED; PG8_LDA(At, 1, 0); PG8_STAGE(PG8_SA(0, 1), a2 + hstep, voffA);
            PG8_WAIT_V(8); PG8_WAIT_L(0); PG8_BAR; PG8_MMA(0, 0, At, B0); PG8_MMA(0, 1, At, B1); PG8_BAR; PG8_SCHED;
            PG8_LDA(At, 1, 1); PG8_STAGE(PG8_SB(1, 0), b3, voffB); PG8_STAGE(PG8_SB(1, 1), b3 + hstep, voffB); PG8_STAGE(PG8_SA(1, 0), a3, voffA);
            PG8_WAIT_V(8); PG8_WAIT_L(0); PG8_BAR; PG8_MMA(1, 0, At, B0); PG8_MMA(1, 1, At, B1); PG8_BAR; PG8_SCHED;
        }
        if constexpr (ALIGN_EPI) { if (wr == 0) PG8_BAR; }
        if constexpr (!Epi::AFTER_DRAIN) { E(acc, cur, wr, wc, fr, fq); S.done(cur); }
        if (!has_next) break;
#pragma unroll
        for (int a = 0; a < 2; ++a)
#pragma unroll
            for (int b = 0; b < 2; ++b)
#pragma unroll
                for (int m = 0; m < 4; ++m)
#pragma unroll
                    for (int n = 0; n < 2; ++n) acc[a][b][m][n] = (f32x4){0.f, 0.f, 0.f, 0.f};
        cur = nxt; cA = nA; cB = nB; ++ui;
        if constexpr (ALIGN_EPI) { if (wr == 1) PG8_BAR; }
    }
    PG8_WAIT_V(0);
    if constexpr (!ALIGN_EPI) { if (wr == 0) PG8_BAR; }
    PG8_BAR;
    if constexpr (Epi::AFTER_DRAIN) { E.fused(acc, cur, wr, wc, fr, fq, lds, wid, lane); S.done(cur); }
#undef PG8_SA
#undef PG8_SB
#undef PG8_STAGE
#undef PG8_LDA
#undef PG8_LDB
#undef PG8_MMA
#undef PG8_WAIT_V
#undef PG8_WAIT_L
#undef PG8_BAR
#undef PG8_SCHED
}
}

#define XB_TMO      128
#define XB_XCNT(j)  (256  + 64 * (j))
#define XB_XSUB(j)  (1280 + 64 * (j))
#define XB_XGEN(j)  (2304 + 64 * (j))
#define XB_TOP      3328
#define XB_TOPGEN   3392
#define XCD_BAR_WORDS 3456
#define XB_SPIN_CAP (1u << 22)
__device__ __forceinline__ unsigned xb_ld(unsigned* p)              { return __hip_atomic_load(p, __ATOMIC_RELAXED, __HIP_MEMORY_SCOPE_AGENT); }
__device__ __forceinline__ unsigned xb_add(unsigned* p, unsigned v) { return __hip_atomic_fetch_add(p, v, __ATOMIC_RELAXED, __HIP_MEMORY_SCOPE_AGENT); }
__device__ __forceinline__ unsigned xb_xcc_id() { return (unsigned)__builtin_amdgcn_s_getreg((3 << 11) | 20) & 0xFu; }
#define XB_SPIN(cond, bar) do { unsigned _sp = 0; while (cond) { __builtin_amdgcn_s_sleep(1); \
    if ((++_sp & 255u) == 0u) { if (xb_ld(&(bar)[XB_TMO])) break; if (_sp > XB_SPIN_CAP) { atomicAdd(&(bar)[XB_TMO], 1u); break; } } } } while (0)
struct XcdBarrier { unsigned* bar; unsigned x; volatile LAS unsigned* st; };
__device__ __forceinline__ XcdBarrier xcd_barrier_post(unsigned* bar, volatile LAS unsigned* st) {
    XcdBarrier b; b.bar = bar; b.x = xb_xcc_id(); b.st = st;
    if (threadIdx.x == 0) (void)xb_add(&bar[XB_XCNT(b.x)], 1u);
    return b;
}
__device__ __forceinline__ void xcd_barrier_complete(unsigned* bar, unsigned x, unsigned& nloc, unsigned& nx) {
    const unsigned G = gridDim.x * gridDim.y * gridDim.z;
    unsigned sum, cnt, mine, sp = 0u;
    for (;;) {
        sum = 0u; cnt = 0u; mine = 0u;
#pragma unroll
        for (unsigned j = 0; j < 16; ++j) { const unsigned c = xb_ld(&bar[XB_XCNT(j)]); sum += c; cnt += (c > 0u) ? 1u : 0u; mine = (j == x) ? c : mine; }
        if (sum == G) break;
        __builtin_amdgcn_s_sleep(1);
        if ((++sp & 255u) == 0u) { if (xb_ld(&bar[XB_TMO])) break; if (sp > XB_SPIN_CAP) { atomicAdd(&bar[XB_TMO], 1u); break; } }
    }
    nloc = mine > 0u ? mine : 1u; nx = cnt > 0u ? cnt : 1u;
}
__device__ __forceinline__ void xcd_barrier(const XcdBarrier& b) {
    asm volatile("s_waitcnt vmcnt(0)" ::: "memory");
    __syncthreads();
    if (threadIdx.x == 0) {
        unsigned* bar = b.bar;
        __builtin_amdgcn_s_waitcnt(0);
        unsigned nloc = b.st[0], nx = b.st[1];
        if (nloc == 0u) { xcd_barrier_complete(bar, b.x, nloc, nx); b.st[0] = nloc; b.st[1] = nx; }
        const unsigned old = xb_add(&bar[XB_XSUB(b.x)], 1u);
        const unsigned gen = old / nloc;
        if (old + 1u == (gen + 1u) * nloc) {
            __builtin_amdgcn_fence(__ATOMIC_RELEASE, "agent");
            asm volatile("s_waitcnt vmcnt(0)" ::: "memory");
            const unsigned og = xb_add(&bar[XB_TOP], 1u);
            const unsigned tg = og / nx;
            if (og + 1u == (tg + 1u) * nx) xb_add(&bar[XB_TOPGEN], 1u);
            else XB_SPIN(xb_ld(&bar[XB_TOPGEN]) == tg, bar);
            __builtin_amdgcn_fence(__ATOMIC_ACQUIRE, "agent");
            xb_add(&bar[XB_XGEN(b.x)], 1u);
            asm volatile("s_waitcnt vmcnt(0)" ::: "memory");
        } else {
            XB_SPIN(xb_ld(&bar[XB_XGEN(b.x)]) == gen, bar);
            __builtin_amdgcn_fence(__ATOMIC_ACQUIRE, "agent");
            asm volatile("s_waitcnt vmcnt(0)" ::: "memory");
        }
    }
    __syncthreads();
}

struct Params {
    const float* in[24];
    float* out;
    unsigned char* ws;
};
enum { I_X = 0, I_LN1G, I_LN1B, I_F1G, I_F1U, I_F1D, I_WIN, I_BGATE, I_POOLW, I_POOLS, I_CPK, I_CKW1, I_CKW2, I_CPV, I_CVW1, I_CVW2, I_WOUT, I_LN2G, I_LN2B, I_F2G, I_F2U, I_F2D, I_LN3G, I_LN3B };

template <bool F16, class RowMap>
__device__ __forceinline__ void transpose_cvt(LAS float* tile  , const float* src, int K, int N, RowMap rm, int owner = -1) {
    const int tK = (K + 63) / 64, tN = (N + 63) / 64, tid = tid_fresh();
    const int tbeg = owner < 0 ? (int)blockIdx.x : ((int)blockIdx.x == owner ? 0 : tK * tN), tinc = owner < 0 ? (int)gridDim.x : 1;
    for (int t = tbeg; t < tK * tN; t += 4 * tinc) {
        f32x4 v[4][2];
#pragma unroll
        for (int b = 0; b < 4; ++b) { const int tb = t + b * tinc; const int k0 = (tb / tN) * 64, n0 = (tb % tN) * 64;
#pragma unroll
            for (int i = 0; i < 2; ++i) { const int kr = (tid >> 4) + 32 * i, nc = 4 * (tid & 15);
                v[b][i] = (f32x4){0.f, 0.f, 0.f, 0.f}; if (tb < tK * tN && k0 + kr < K && n0 + nc < N) v[b][i] = *(const f32x4*)(src + (size_t)(k0 + kr) * N + n0 + nc); } }
#pragma unroll
        for (int b = 0; b < 4; ++b)
#pragma unroll
            for (int i = 0; i < 2; ++i) { const int kr = (tid >> 4) + 32 * i, nc = 4 * (tid & 15); LAS float* tl = tile + b * (64 * 65);
                tl[kr * 65 + nc] = v[b][i][0]; tl[kr * 65 + nc + 1] = v[b][i][1]; tl[kr * 65 + nc + 2] = v[b][i][2]; tl[kr * 65 + nc + 3] = v[b][i][3]; }
        __syncthreads();
#pragma unroll
        for (int b = 0; b < 4; ++b) { const int tb = t + b * tinc; const int k0 = (tb / tN) * 64, n0 = (tb % tN) * 64; const LAS float* tl = tile + b * (64 * 65);
          const int nr = tid >> 3, kc = 8 * (tid & 7);
          if (tb < tK * tN && n0 + nr < N && k0 + kc < K) { bf16_t* d = rm(n0 + nr);
              if (d) { u32x4 w;
                       if (F16) { w.x = cvt_pk_f16_b(tl[(kc + 0) * 65 + nr], tl[(kc + 1) * 65 + nr]); w.y = cvt_pk_f16_b(tl[(kc + 2) * 65 + nr], tl[(kc + 3) * 65 + nr]);
                                  w.z = cvt_pk_f16_b(tl[(kc + 4) * 65 + nr], tl[(kc + 5) * 65 + nr]); w.w = cvt_pk_f16_b(tl[(kc + 6) * 65 + nr], tl[(kc + 7) * 65 + nr]); }
                       else     { w.x = cvt_pk_bf16(tl[(kc + 0) * 65 + nr], tl[(kc + 1) * 65 + nr]); w.y = cvt_pk_bf16(tl[(kc + 2) * 65 + nr], tl[(kc + 3) * 65 + nr]);
                                  w.z = cvt_pk_bf16(tl[(kc + 4) * 65 + nr], tl[(kc + 5) * 65 + nr]); w.w = cvt_pk_bf16(tl[(kc + 6) * 65 + nr], tl[(kc + 7) * 65 + nr]); }
                       *(u32x4*)(d + k0 + kc) = w; } } }
        __syncthreads();
    }
}

__device__ void p0_phase(const Params& p, LAS unsigned char* lds) {
    LAS float* tile = (LAS float*)lds;
    unsigned char* ws = p.ws;
    const int tid = tid_fresh();
    for (int l = 0; l < 2; ++l) {
        for (int f = 0; f < 2; ++f) {
            bf16_t* wgu = (bf16_t*)(ws + WS_WGU + (size_t)(l * 2 + f) * SZ_WGU);
            bf16_t* wdn = (bf16_t*)(ws + WS_WDN + (size_t)(l * 2 + f) * SZ_WDN);
            const float* sg = p.in[f ? I_F2G : I_F1G] + (size_t)l * DM * DFF;
            const float* su = p.in[f ? I_F2U : I_F1U] + (size_t)l * DM * DFF;
            const float* sd = p.in[f ? I_F2D : I_F1D] + (size_t)l * DFF * DM;
            transpose_cvt<true>(tile, sg, DM, DFF, [=](int n) { return wgu + (size_t)((n >> 7) * 256 + (n & 127)) * DM; });
            transpose_cvt<true>(tile, su, DM, DFF, [=](int n) { return wgu + (size_t)((n >> 7) * 256 + 128 + (n & 127)) * DM; });
            transpose_cvt<true>(tile, sd, DFF, DM, [=](int n) { return wdn + (size_t)n * DFF; });
        }
        bf16_t* win = (bf16_t*)(ws + WS_WIN + (size_t)l * SZ_WIN);
        bf16_t* wvt = (bf16_t*)(ws + WS_WVT + (size_t)l * SZ_WVT);
        transpose_cvt<true>(tile, p.in[I_WIN] + (size_t)l * DM * 2200, DM, 2200, [=](int n) -> bf16_t* {
            if (n < 1600) return win + (size_t)n * DM;
            if (n < 1792) return wvt + (size_t)(n - 1600) * DM;
            if (n < 1984) return win + (size_t)(n - 1792 + C_KW) * DM;
            if (n < 2176) return wvt + (size_t)(n - 1984 + 192) * DM;
            return win + (size_t)(n - 2176 + C_G) * DM; });
        { u32x4 z = {0u, 0u, 0u, 0u};
          u32x4* a = (u32x4*)(win + (size_t)1816 * DM); const size_t na = (size_t)(2048 - 1816) * DM * 2 / 16;
          for (size_t i = (size_t)blockIdx.x * 512 + tid; i < na; i += (size_t)gridDim.x * 512) a[i] = z;
          u32x4* b = (u32x4*)(wvt + (size_t)384 * DM); const size_t nb = (size_t)(512 - 384) * DM * 2 / 16;
          for (size_t i = (size_t)blockIdx.x * 512 + tid; i < nb; i += (size_t)gridDim.x * 512) b[i] = z; }
        bf16_t* wout = (bf16_t*)(ws + WS_WOUT + (size_t)l * SZ_WOUT);
        transpose_cvt<true>(tile, p.in[I_WOUT] + (size_t)l * DM * DM, DM, DM, [=](int n) { return wout + (size_t)n * DM; });
        for (int kv = 0; kv < 2; ++kv) {
            bf16_t* wc1 = (bf16_t*)(ws + WS_WC1 + (size_t)(l * 2 + kv) * SZ_WC1);
            bf16_t* wc2 = (bf16_t*)(ws + WS_WC2 + (size_t)(l * 2 + kv) * SZ_WC2);
            transpose_cvt<false>(tile, p.in[kv ? I_CVW1 : I_CKW1] + (size_t)l * 3072 * 96, 3072, 96, [=](int n) { return wc1 + (size_t)n * 3072; });
            transpose_cvt<false>(tile, p.in[kv ? I_CVW2 : I_CKW2] + (size_t)l * 96 * 96, 96, 96, [=](int n) { return wc2 + (size_t)n * 96; }, 8 + l * 2 + kv);
        }
    }
    if (blockIdx.x < 128) {
        const int which = blockIdx.x >> 5, chunk = blockIdx.x & 31, l = which >> 1, kv = which & 1;
        const float* pos = p.in[kv ? I_CPV : I_CPK] + (size_t)l * 3072;
        const float* w1 = p.in[kv ? I_CVW1 : I_CKW1] + (size_t)l * 3072 * 96;
        float* part = (float*)(ws + WS_POSP) + (size_t)(which * 32 + chunk) * 96;
        LAS float* red = (LAS float*)lds;
        const int c = tid % 96, sub = tid / 96;
        float s = 0.f;
        if (sub < 5) { for (int k = chunk * 96 + sub; k < chunk * 96 + 96; k += 5) s += pos[k] * w1[(size_t)k * 96 + c]; red[sub * 96 + c] = s; }
        __syncthreads();
        if (tid < 96) part[tid] = red[tid] + red[96 + tid] + red[192 + tid] + red[288 + tid] + red[384 + tid];
        __syncthreads();
    }
    { const f32x4* x4 = (const f32x4*)p.in[I_X]; u32x2* xb = (u32x2*)(ws + WS_XB); const size_t n4 = (size_t)MTOK * DM / 4;
      const size_t stride = (size_t)gridDim.x * 512;
      size_t i = (size_t)blockIdx.x * 512 + tid;
      for (; i + 7 * stride < n4; i += 8 * stride) { f32x4 v[8];
#pragma unroll
          for (int k = 0; k < 8; ++k) v[k] = x4[i + k * stride];
#pragma unroll
          for (int k = 0; k < 8; ++k) { u32x2 w; w.x = cvt_pk_f16(v[k][0], v[k][1]); w.y = cvt_pk_f16(v[k][2], v[k][3]); xb[i + k * stride] = w; } }
      for (; i < n4; i += stride) { const f32x4 v = x4[i]; u32x2 w; w.x = cvt_pk_f16(v[0], v[1]); w.y = cvt_pk_f16(v[2], v[3]); xb[i] = w; } }
}

__device__ __forceinline__ float gelu_tanh(float x) { const float u = 0.7978845608028654f * (x + 0.044715f * x * x * x); const float t = 1.0f - 2.0f / (1.0f + __expf(2.0f * u)); return 0.5f * x * (1.0f + t); }

__device__ void compress_item(LAS unsigned char* lds, int item, const bf16_t* proj, const unsigned char* ws, int l, bf16_t* kcmp, bf16_t* vcmpT) {
    const int tid = tid_fresh(), wid = tid >> 6, lane = tid & 63, c16 = lane & 15, hh = lane >> 4;
    const int rt = item & 31, kv = (item >> 5) & 1, bg = item >> 6, b = bg >> 1, g = bg & 1;
    const int n0 = 32 * rt, tok0 = 16 * n0, col0 = (kv ? C_VC : C_KC) + g * 96;
    const bf16_t* w1t = (const bf16_t*)(ws + WS_WC1 + (size_t)(l * 2 + kv) * SZ_WC1);
    const bf16_t* w2t = (const bf16_t*)(ws + WS_WC2 + (size_t)(l * 2 + kv) * SZ_WC2);
    const float* posp = (const float*)(ws + WS_POSP) + (size_t)(l * 2 + kv) * 32 * 96;
    { u32x4 v[13];
#pragma unroll
      for (int k = 0; k < 13; ++k) { const int i = tid + 512 * k; if (i < 528 * 12) { const int tl = i / 12, ch = i % 12; int tok = tok0 + tl; tok = tok < SEQ ? tok : SEQ - 1;
          v[k] = *(const u32x4*)(proj + (size_t)(b * SEQ + tok) * NPROJ + col0 + ch * 8); } }
#pragma unroll
      for (int k = 0; k < 13; ++k) { const int i = tid + 512 * k; if (i < 528 * 12) { const int tl = i / 12, ch = i % 12;
          *(LAS u32x4*)(lds + ((tl & 15) * 33 + (tl >> 4)) * 208 + ch * 16) = v[k]; } } }
    __syncthreads();
    f32x4 acc[2][6];
#pragma unroll
    for (int a = 0; a < 2; ++a)
#pragma unroll
        for (int c = 0; c < 6; ++c) acc[a][c] = (f32x4){0.f, 0.f, 0.f, 0.f};
    for (int jj = 0; jj < 4; ++jj) { const int j = 4 * wid + jj, r = j & 15, qoff = j >> 4;
#pragma unroll
        for (int ds = 0; ds < 3; ++ds) {
            bf16x8 a[2];
#pragma unroll
            for (int r2 = 0; r2 < 2; ++r2) a[r2] = *(const LAS bf16x8*)(lds + (r * 33 + 16 * r2 + c16 + qoff) * 208 + (32 * ds + 8 * hh) * 2);
#pragma unroll
            for (int ct = 0; ct < 6; ++ct) { const bf16x8 bf = *(const bf16x8*)(w1t + (size_t)(16 * ct + c16) * 3072 + j * 96 + 32 * ds + 8 * hh);
#pragma unroll
                for (int r2 = 0; r2 < 2; ++r2) acc[r2][ct] = __builtin_amdgcn_mfma_f32_16x16x32_bf16(a[r2], bf, acc[r2][ct], 0, 0, 0); }
        } }
    __syncthreads();
    LAS float* part = (LAS float*)lds;
#pragma unroll
    for (int r2 = 0; r2 < 2; ++r2)
#pragma unroll
        for (int ct = 0; ct < 6; ++ct)
#pragma unroll
            for (int r = 0; r < 4; ++r) part[(wid * 32 + 16 * r2 + 4 * hh + r) * 96 + 16 * ct + c16] = acc[r2][ct][r];
    LAS float* posw = (LAS float*)(lds + 98304 + 32 * 208);
    if (tid < 96) { float ps = 0.f;
#pragma unroll 8
        for (int ch = 0; ch < 32; ++ch) ps += posp[ch * 96 + tid];
        posw[tid] = ps; }
    __syncthreads();
    LAS unsigned char* hsm = lds + 98304;
    for (int idx = tid; idx < 32 * 96; idx += 512) { const int n = idx / 96, cc = idx % 96; float s = posw[cc];
#pragma unroll
        for (int w = 0; w < 8; ++w) s += part[(w * 32 + n) * 96 + cc];
        *(LAS bf16_t*)(hsm + n * 208 + cc * 2) = f2bf(gelu_tanh(s)); }
    __syncthreads();
    if (wid < 6) { const int ct = wid;
#pragma unroll
        for (int r2 = 0; r2 < 2; ++r2) { f32x4 o = {0.f, 0.f, 0.f, 0.f};
#pragma unroll
            for (int ks = 0; ks < 3; ++ks) { const bf16x8 a = *(const LAS bf16x8*)(hsm + (16 * r2 + c16) * 208 + (32 * ks + 8 * hh) * 2);
                const bf16x8 bf = *(const bf16x8*)(w2t + (size_t)(16 * ct + c16) * 96 + 32 * ks + 8 * hh);
                o = __builtin_amdgcn_mfma_f32_16x16x32_bf16(a, bf, o, 0, 0, 0); }
#pragma unroll
            for (int r = 0; r < 4; ++r) { const int n = n0 + 16 * r2 + 4 * hh + r, cc = 16 * ct + c16; const bf16_t v = (n == 1023) ? (bf16_t)0 : f2bf(o[r]);
                if (kv == 0) kcmp[(size_t)(bg * 1024 + n) * 96 + cc] = v; else vcmpT[(size_t)((bg * 32 + rt) * 96 + cc) * 32 + (n - n0)] = v; } } }
    __syncthreads();
}

__device__ void pool_item(LAS unsigned char* lds, int item, const bf16_t* proj, const float* pool_w, const float* pool_scale, bf16_t* concat) {
    const int tid = tid_fresh();
    const int row0 = item * 64, tpos0 = row0 & (SEQ - 1);
    LAS bf16_t* ub = (LAS bf16_t*)lds;
    LAS float* pT = (LAS float*)(lds + 40448);
    { u32x4 v[5];
#pragma unroll
      for (int k = 0; k < 5; ++k) { const int i = tid + 512 * k; v[k] = (u32x4){0u, 0u, 0u, 0u}; if (i < 79 * 32) { const int rr = i >> 5, ch = i & 31; const int tp = tpos0 - 15 + rr;
          if (tp >= 0) v[k] = *(const u32x4*)(proj + (size_t)(row0 - 15 + rr) * NPROJ + ch * 8); } }
#pragma unroll
      for (int k = 0; k < 5; ++k) { const int i = tid + 512 * k; if (i < 79 * 32) { const int rr = i >> 5, ch = i & 31; *(LAS u32x4*)(lds + rr * 512 + ch * 16) = v[k]; } } }
    __syncthreads();
#pragma unroll 4
    for (int i = 0; i < 32; ++i) { const int idx = tid + 512 * i, ch = idx & 255, tl = idx >> 8, g = ch >> 6, w = 2 << g;
        const int tp = tpos0 + tl; const float cnt = (float)((tp + 1) < w ? (tp + 1) : w);
        float s = 0.f; for (int k = 0; k < w; ++k) s += bf2f(ub[(15 + tl - k) * 256 + ch]);
        pT[ch * 68 + tl] = s / cnt - bf2f(ub[(15 + tl) * 256 + ch]); }
    __syncthreads();
    { const int co = tid & 255, th = tid >> 8, g = co >> 6, dd = co & 63;
      float acc[32];
#pragma unroll
      for (int i = 0; i < 32; ++i) acc[i] = 0.f;
      float wreg[64];
#pragma unroll
      for (int cc = 0; cc < 64; ++cc) wreg[cc] = pool_w[(size_t)(g * 64 + cc) * 64 + dd];
#pragma unroll
      for (int cc = 0; cc < 64; ++cc) { const float wv = wreg[cc];
#pragma unroll
          for (int i4 = 0; i4 < 8; ++i4) { const f32x4 pv = *(const LAS f32x4*)(pT + (g * 64 + cc) * 68 + th * 32 + 4 * i4);
              acc[4 * i4 + 0] += pv[0] * wv; acc[4 * i4 + 1] += pv[1] * wv; acc[4 * i4 + 2] += pv[2] * wv; acc[4 * i4 + 3] += pv[3] * wv; } }
      const float sc = pool_scale[co];
#pragma unroll
      for (int i = 0; i < 32; ++i) concat[(size_t)(row0 + th * 32 + i) * DM + co] = f2h(acc[i] * sc); }
    __syncthreads();
}

constexpr int A_KSZ = 64 * 192, A_VSZ = 96 * 128, A_BUF = A_KSZ + A_VSZ,
              A_IMP = 3 * A_BUF, A_IMPW = 260, A_PLAN = LDS_BYTES - 16 - 512 * 16, A_SEL = A_PLAN - 64 * 8 * 4, A_END = LDS_BYTES - 16;
constexpr int SLC_CH = 3;
static_assert(A_IMP + 64 * A_IMPW * 4 <= A_SEL && 2 * SLC_CH * A_BUF <= A_SEL, "attn lds");
constexpr float SM_SC = 0.10206207261596577f * 1.4426950408889634f;
constexpr float NEGB = -1e30f;
enum { MODE_WIN = 0, MODE_CMP = 1, MODE_SLC = 2 };

template <bool VCH>
__device__ __forceinline__ void dma_plan(LAS unsigned char* lds, unsigned kstride, unsigned vstride, int wid, int lane, int tid) {
    u32x4 g = {0u, 0u, 0u, 0u};
#pragma unroll
    for (int j = 0; j < 3; ++j) { const int sidx = wid + 8 * j; const bool isK = sidx < 12; const int piece = isK ? sidx : sidx - 12; const int o = piece * 1024 + 16 * lane;
        unsigned goff;
        if (isK) { const int r = o / 192, ph = (o % 192) >> 4, f = (4 - ((r >> 2) & 3)) & 3, u = (ph & ~3) | ((ph & 3) ^ f); goff = (unsigned)r * kstride + u * 8; }
        else { const int d = o >> 7, ph = (o & 127) >> 4, w = ph ^ ((d >> 1) & 7); goff = VCH ? (unsigned)(((w >> 2) * 96 + d) * 32 + (w & 3) * 8) : (unsigned)d * vstride + w * 8; }
        g[j] = goff; }
    *(LAS u32x4*)(lds + A_PLAN + tid * 16) = g;
}
template <bool VCH>
__device__ __forceinline__ void dma_issue(LAS unsigned char* lds, int buf, int T, const bf16_t* kb, unsigned kstride, const bf16_t* vb, int wid, int tid) {
    const u32x4 g = *(const LAS u32x4*)(lds + A_PLAN + tid * 16);
#pragma unroll
    for (int j = 0; j < 3; ++j) { const int sidx = wid + 8 * j;
        const bool isK = sidx < 12; const int piece = isK ? sidx : sidx - 12;
        const bf16_t* tb = isK ? kb + (size_t)T * 64u * kstride : vb + (size_t)T * (VCH ? 6144u : 64u);
        __builtin_amdgcn_global_load_lds((const unsigned*)(tb + g[j]), (LAS unsigned*)(lds + buf * A_BUF + (isK ? 0 : A_KSZ) + piece * 1024), 16, 0, 0); }
}

template <int MODE>
__device__ __forceinline__ bool key_valid(int kk, int tok) {
    if (MODE == MODE_WIN) return (kk <= tok) && (tok - kk < 512);
    if (MODE == MODE_CMP) return (16 * kk + 31) <= tok;
    return kk <= tok;
}

template <int MODE, int QM>
__device__ __forceinline__ void tile_compute(LAS const unsigned char* ks, LAS const unsigned char* vs, int T, bool masked, const bf16x8 (&qf)[2][3], const int (&tok)[2], const bool (&selq)[2],
                                             f32x4 (&O)[2][6], float (&m)[2], float (&ls)[2], int c16, int hh) {
    const int kro = c16 * 192 + ((hh ^ ((4 - ((c16 >> 2) & 3)) & 3)) << 4);
    int vro[4];
#pragma unroll
    for (int j = 0; j < 4; ++j) vro[j] = c16 * 128 + ((((2 * j) | (hh >> 1)) ^ ((c16 >> 1) & 7)) << 4) + 8 * (hh & 1);
    f32x4 s[2][4];
    __builtin_amdgcn_s_setprio(1);
#pragma unroll
    for (int kt = 0; kt < 4; ++kt) {
#pragma unroll
        for (int k3 = 0; k3 < 3; ++k3) { const bf16x8 a = *(const LAS bf16x8*)(ks + kro + kt * 3072 + k3 * 64);
#pragma unroll
            for (int q = 0; q < 2; ++q) if ((QM >> q) & 1) s[q][kt] = __builtin_amdgcn_mfma_f32_16x16x32_bf16(a, qf[q][k3], (k3 == 0) ? (f32x4){0.f, 0.f, 0.f, 0.f} : s[q][kt], 0, 0, 0); } }
    __builtin_amdgcn_s_setprio(0);
    bf16x8 pb[2][2];
#pragma unroll
    for (int q = 0; q < 2; ++q) if ((QM >> q) & 1) {
        if (masked) {
#pragma unroll
            for (int kt = 0; kt < 4; ++kt)
#pragma unroll
                for (int r = 0; r < 4; ++r) { const int kk = 64 * T + 16 * kt + 4 * hh + r; s[q][kt][r] = key_valid<MODE>(kk, tok[q]) ? s[q][kt][r] : -1e35f; }
        }
        float mloc = -1e20f;
#pragma unroll
        for (int kt = 0; kt < 4; ++kt)
#pragma unroll
            for (int r = 0; r < 4; ++r) mloc = fmaxf(mloc, s[q][kt][r]);
        if (MODE == MODE_SLC) mloc = selq[q] ? mloc : -1e20f;
        mloc = xr32_max(xr16_max(mloc));
        const float mn = fmaxf(m[q], mloc), al = __builtin_amdgcn_exp2f((m[q] - mn) * SM_SC); m[q] = mn;
        const float nb = (MODE == MODE_SLC && !selq[q]) ? -1e35f : -mn * SM_SC;
        float lsum = 0.f;
#pragma unroll
        for (int kt = 0; kt < 4; ++kt)
#pragma unroll
            for (int r = 0; r < 4; ++r) { const float pv = __builtin_amdgcn_exp2f(fmaf(s[q][kt][r], SM_SC, nb)); s[q][kt][r] = pv; lsum += pv; }
        ls[q] = ls[q] * al + lsum;
        if (__builtin_amdgcn_ballot_w64(al != 1.0f) != 0ull) {
#pragma unroll
            for (int dt = 0; dt < 6; ++dt) O[q][dt] *= al; }
#pragma unroll
        for (int s2 = 0; s2 < 2; ++s2) { u32x4 w; w.x = cvt_pk_bf16(s[q][2 * s2][0], s[q][2 * s2][1]); w.y = cvt_pk_bf16(s[q][2 * s2][2], s[q][2 * s2][3]);
            w.z = cvt_pk_bf16(s[q][2 * s2 + 1][0], s[q][2 * s2 + 1][1]); w.w = cvt_pk_bf16(s[q][2 * s2 + 1][2], s[q][2 * s2 + 1][3]); pb[q][s2] = __builtin_bit_cast(bf16x8, w); }
    }
    __builtin_amdgcn_s_setprio(1);
#pragma unroll
    for (int dt = 0; dt < 6; ++dt)
#pragma unroll
        for (int s2 = 0; s2 < 2; ++s2) { const u32x2 lo = *(const LAS u32x2*)(vs + dt * 2048 + vro[2 * s2]), hi = *(const LAS u32x2*)(vs + dt * 2048 + vro[2 * s2 + 1]);
            u32x4 w; w.x = lo.x; w.y = lo.y; w.z = hi.x; w.w = hi.y; const bf16x8 a = __builtin_bit_cast(bf16x8, w);
#pragma unroll
            for (int q = 0; q < 2; ++q) if ((QM >> q) & 1) O[q][dt] = __builtin_amdgcn_mfma_f32_16x16x32_bf16(a, pb[q][s2], O[q][dt], 0, 0, 0); }
    __builtin_amdgcn_s_setprio(0);
}

__device__ __forceinline__ void imp_compute(LAS const unsigned char* ks, int T, const bf16x8 (&qf)[2][3], const int (&tok)[2], const int (&tokl)[2], const float (&m)[2], const float (&rl)[2], LAS float* imp, int c16, int hh) {
    const int kro = c16 * 192 + ((hh ^ ((4 - ((c16 >> 2) & 3)) & 3)) << 4);
#pragma unroll
    for (int kt = 0; kt < 4; ++kt) { f32x4 s[2] = {{0.f, 0.f, 0.f, 0.f}, {0.f, 0.f, 0.f, 0.f}};
#pragma unroll
        for (int k3 = 0; k3 < 3; ++k3) { const bf16x8 a = *(const LAS bf16x8*)(ks + kro + kt * 3072 + k3 * 64);
#pragma unroll
            for (int q = 0; q < 2; ++q) s[q] = __builtin_amdgcn_mfma_f32_16x16x32_bf16(a, qf[q][k3], s[q], 0, 0, 0); }
#pragma unroll
        for (int q = 0; q < 2; ++q) { float pv[4];
#pragma unroll
            for (int r = 0; r < 4; ++r) { const int kk = 64 * T + 16 * kt + 4 * hh + r; pv[r] = key_valid<MODE_CMP>(kk, tok[q]) ? __builtin_amdgcn_exp2f((s[q][r] - m[q]) * SM_SC) * rl[q] : 0.f; }
            float a = (pv[0] + pv[1]) + (pv[2] + 0.5f * pv[3]), bb = 0.5f * pv[3];
            a += dpp_f<DPP_XOR1>(a); a += dpp_f<DPP_XOR2>(a); bb += dpp_f<DPP_XOR1>(bb); bb += dpp_f<DPP_XOR2>(bb);
            if ((c16 & 3) == 0) { const int jj = 16 * T + 4 * kt + hh; LAS float* ip = imp + tokl[q] * A_IMPW + jj;
                __hip_atomic_fetch_add(ip, a, __ATOMIC_RELAXED, __HIP_MEMORY_SCOPE_WORKGROUP); __hip_atomic_fetch_add(ip + 1, bb, __ATOMIC_RELAXED, __HIP_MEMORY_SCOPE_WORKGROUP); } } }
}

template <int MODE, bool IMP, int NBS, int CH>
__device__ __forceinline__ void flash_branch(LAS unsigned char* lds, const bf16_t* kb, unsigned kstride, const bf16_t* vb, unsigned vstride, int T_lo, int T_hi, int c,
                                             const bf16x8 (&qf)[2][3], const int (&tok)[2], const int (&tokl)[2], f32x4 (&O)[2][6], float (&m)[2], float (&ls)[2]) {
    static_assert((NBS == 3 && CH == 1) || NBS == 2, "wait counts below");
    const int tid = tid_fresh(), lane = tid & 63, c16 = lane & 15, hh = lane >> 4, wid = __builtin_amdgcn_readfirstlane(tid >> 6);
    float rl[2] = {0.f, 0.f};
    if (!IMP) {
#pragma unroll
        for (int q = 0; q < 2; ++q) { m[q] = -1e20f; ls[q] = 0.f;
#pragma unroll
            for (int dt = 0; dt < 6; ++dt) O[q][dt] = (f32x4){0.f, 0.f, 0.f, 0.f}; }
    } else { rl[0] = 1.0f / fmaxf(ls[0], 1e-30f); rl[1] = 1.0f / fmaxf(ls[1], 1e-30f); }
    dma_plan<MODE == MODE_CMP>(lds, kstride, vstride, wid, lane, tid);
#pragma unroll
    for (int d = 0; d < NBS - 1; ++d)
#pragma unroll
        for (int t = 0; t < CH; ++t) { const int Tn = T_lo + d * CH + t; dma_issue<MODE == MODE_CMP>(lds, d * CH + t, Tn <= T_hi ? Tn : T_hi, kb, kstride, vb, wid, tid); }
    int sb = 0;
    for (int Ts = T_lo; Ts <= T_hi; Ts += CH) {
        if (NBS == 3) asm volatile("s_waitcnt vmcnt(3)" ::: "memory"); else asm volatile("s_waitcnt vmcnt(0)" ::: "memory");
        __builtin_amdgcn_s_barrier();
        asm volatile("" ::: "memory");
        { const int nb = (sb == 0) ? NBS - 1 : sb - 1;
#pragma unroll
          for (int t = 0; t < CH; ++t) { const int Tn = Ts + (NBS - 1) * CH + t; dma_issue<MODE == MODE_CMP>(lds, nb * CH + t, Tn <= T_hi ? Tn : T_hi, kb, kstride, vb, wid, tid); } }
#pragma unroll 1
        for (int t = 0; t < CH; ++t) { const int T = Ts + t; if (T > T_hi) break;
            LAS const unsigned char* ks = lds + (sb * CH + t) * A_BUF; LAS const unsigned char* vs = ks + A_KSZ;
            if (IMP) imp_compute(ks, T, qf, tok, tokl, m, rl, (LAS float*)(lds + A_IMP), c16, hh);
            else {
                bool selq[2] = {true, true};
                bool masked;
                if (MODE == MODE_WIN) masked = (T == c) || (T == c - 8);
                else if (MODE == MODE_CMP) masked = (1024 * T + 1039 > 64 * c);
                else masked = (T == c);
                if (MODE == MODE_SLC) {
                    LAS const unsigned* selw = (LAS const unsigned*)(lds + A_SEL);
                    int qm = 0;
#pragma unroll
                    for (int q = 0; q < 2; ++q) { selq[q] = (selw[tokl[q] * 8 + (T >> 5)] >> (T & 31)) & 1u; if (__builtin_amdgcn_ballot_w64(selq[q]) != 0ull) qm |= 1 << q; }
                    if (qm == 3) tile_compute<MODE, 3>(ks, vs, T, masked, qf, tok, selq, O, m, ls, c16, hh);
                    else if (qm == 1) tile_compute<MODE, 1>(ks, vs, T, masked, qf, tok, selq, O, m, ls, c16, hh);
                    else if (qm == 2) tile_compute<MODE, 2>(ks, vs, T, masked, qf, tok, selq, O, m, ls, c16, hh);
                } else tile_compute<MODE, 3>(ks, vs, T, masked, qf, tok, selq, O, m, ls, c16, hh);
            } }
        sb = (sb + 1 >= NBS) ? 0 : sb + 1;
    }
    asm volatile("s_waitcnt vmcnt(0) lgkmcnt(0)" ::: "memory");
    __builtin_amdgcn_s_barrier();
    asm volatile("" ::: "memory");
}

__device__ void attn_item(LAS unsigned char* lds, int b, int g, int c, const bf16_t* proj, const bf16_t* vtb, const bf16_t* kcmp, const bf16_t* vcmpT, const float* bgate, bf16_t* concat) {
    const int tid = tid_fresh(), wid = tid >> 6, lane = tid & 63, c16 = lane & 15, hh = lane >> 4;
    const int bg = b * 2 + g, t0 = 64 * c;
    int tok[2], tokl[2]; bf16x8 qf[2][3];
    const int head8 = g * 4 + (c16 & 3);
#pragma unroll
    for (int q = 0; q < 2; ++q) { tokl[q] = 8 * wid + 4 * q + (c16 >> 2); tok[q] = t0 + tokl[q];
        const bf16_t* rowp = proj + (size_t)(b * SEQ + tok[q]) * NPROJ;
#pragma unroll
        for (int k3 = 0; k3 < 3; ++k3) qf[q][k3] = *(const bf16x8*)(rowp + C_Q + head8 * 96 + 32 * k3 + 8 * hh); }
    f32x4 O[2][6]; float m[2], ls[2];
    { LAS float* imp = (LAS float*)(lds + A_IMP); for (int i = tid; i < 64 * A_IMPW; i += 512) imp[i] = 0.f; }
    asm volatile("s_waitcnt vmcnt(0)" ::: "memory");
typedef _Float16 f16x8v __attribute__((ext_vector_type(8)));
#define FINALIZE(br, FIRST) do { _Pragma("unroll") for (int q = 0; q < 2; ++q) { float l = xr32_sum(xr16_sum(ls[q])); ls[q] = l; \
        int tq_ = tok[q]; asm volatile("" : "+v"(tq_)); const bf16_t* rowp = proj + (size_t)(b * SEQ + tq_) * NPROJ; const float gx = bf2f(rowp[C_G + head8 * 3 + br]) + bgate[head8 * 3 + br]; \
        const float inv = (1.0f / (1.0f + __expf(-gx))) / fmaxf(l, 1e-30f); \
        LAS unsigned char* sp = lds + tokl[q] * 784 + ((c16 & 3) * 96 + 4 * hh) * 2; \
        _Pragma("unroll") for (int dt = 0; dt < 6; ++dt) { const f32x4 v = O[q][dt] * inv; *(LAS u32x2*)(sp + 32 * dt) = (u32x2){cvt_pk_f16(v[0], v[1]), cvt_pk_f16(v[2], v[3])}; } } \
        asm volatile("s_waitcnt vmcnt(0) lgkmcnt(0)" ::: "memory"); __builtin_amdgcn_s_barrier(); asm volatile("" ::: "memory"); \
        { int tf_ = tid; asm volatile("" : "+v"(tf_)); \
        _Pragma("unroll") for (int rnd = 0; rnd < 3; ++rnd) { u32x4 nv[2], ov[2]; \
          _Pragma("unroll") for (int i = 0; i < 2; ++i) { const int id = tf_ + 512 * (2 * rnd + i), row = id / 48, ch = id % 48; nv[i] = *(const LAS u32x4*)(lds + row * 784 + ch * 16); \
              if (!(FIRST)) ov[i] = *(const u32x4*)(concat + (size_t)(b * SEQ + t0 + row) * DM + 256 + g * 384 + ch * 8); } \
          _Pragma("unroll") for (int i = 0; i < 2; ++i) { const int id = tf_ + 512 * (2 * rnd + i), row = id / 48, ch = id % 48; u32x4 r = nv[i]; \
              if (!(FIRST)) r = __builtin_bit_cast(u32x4, __builtin_bit_cast(f16x8v, nv[i]) + __builtin_bit_cast(f16x8v, ov[i])); \
              *(u32x4*)(concat + (size_t)(b * SEQ + t0 + row) * DM + 256 + g * 384 + ch * 8) = r; } } } \
        asm volatile("s_waitcnt vmcnt(0) lgkmcnt(0)" ::: "memory"); __builtin_amdgcn_s_barrier(); asm volatile("" ::: "memory"); } while (0)
    { const int T_lo = (c - 8) > 0 ? (c - 8) : 0;
      flash_branch<MODE_WIN, false, 3, 1>(lds, proj + (size_t)b * SEQ * NPROJ + C_KW + g * 96, NPROJ, vtb + (size_t)(192 + g * 96) * MTOK + (size_t)b * SEQ, MTOK, T_lo, c, c, qf, tok, tokl, O, m, ls);
      FINALIZE(2, true); }
    const int Tc = (4 * c + 2) >> 6;
    const bf16_t* kcb = kcmp + (size_t)bg * 1024 * 96; const bf16_t* vcb = vcmpT + (size_t)bg * 96 * 1024;
    flash_branch<MODE_CMP, false, 3, 1>(lds, kcb, 96, vcb, 1024, 0, Tc, c, qf, tok, tokl, O, m, ls);
    FINALIZE(0, false);
    if (c >= 16) flash_branch<MODE_CMP, true, 3, 1>(lds, kcb, 96, vcb, 1024, 0, Tc, c, qf, tok, tokl, O, m, ls);
    { LAS unsigned* selw = (LAS unsigned*)(lds + A_SEL); LAS const float* imp = (LAS const float*)(lds + A_IMP);
#pragma unroll 2
      for (int i = 0; i < 8; ++i) { const int tl = 8 * wid + i;
          if (c <= 15) { if (lane < 8) selw[tl * 8 + lane] = (lane == 0) ? ((2u << c) - 1u) : 0u; }
          else {
              unsigned key[4]; unsigned picked = 0;
#pragma unroll
              for (int q4 = 0; q4 < 4; ++q4) { const int j = lane + 64 * q4; const bool ok = (j >= 1) && (j <= c - 2);
                  key[q4] = ok ? ((__float_as_uint(imp[tl * A_IMPW + j]) & 0xFFFFFF00u) | (unsigned)(255 - j)) : 0u; }
#pragma unroll 1
              for (int rnd = 0; rnd < 13; ++rnd) {
                  unsigned best = max(max(key[0], key[1]), max(key[2], key[3]));
                  { const auto a = __builtin_amdgcn_permlane32_swap(best, best, false, false); best = max(a[0], a[1]); }
                  { const auto a = __builtin_amdgcn_permlane16_swap(best, best, false, false); best = max(a[0], a[1]); }
                  best = max(best, dpp_u<DPP_XOR1>(best)); best = max(best, dpp_u<DPP_XOR2>(best)); best = max(best, dpp_u<DPP_ROR4>(best)); best = max(best, dpp_u<DPP_ROR8>(best));
#pragma unroll
                  for (int q4 = 0; q4 < 4; ++q4) if (key[q4] == best && best != 0u) { key[q4] = 0u; picked |= 1u << q4; }
              }
#pragma unroll
              for (int q4 = 0; q4 < 4; ++q4) { const int j = lane + 64 * q4; const bool on = ((picked >> q4) & 1u) || j == 0 || j == c - 1 || j == c;
                  const unsigned long long bal = __builtin_amdgcn_ballot_w64(on);
                  if (lane == 0) { selw[tl * 8 + 2 * q4] = (unsigned)bal; selw[tl * 8 + 2 * q4 + 1] = (unsigned)(bal >> 32); } }
          } } }
    __syncthreads();
    flash_branch<MODE_SLC, false, 2, SLC_CH>(lds, proj + (size_t)b * SEQ * NPROJ + C_KS + g * 96, NPROJ, vtb + (size_t)(g * 96) * MTOK + (size_t)b * SEQ, MTOK, 0, c, c, qf, tok, tokl, O, m, ls);
    FINALIZE(1, false);
#undef FINALIZE
}

__device__ __forceinline__ void gemm_ln(LAS unsigned char* lds, unsigned char* ws, int gid, const bf16_t* A, int K, const bf16_t* Bt, float* xf  , bf16_t* xb,
                                        const float* gam, const float* bet, float alpha, float beta, int G, int bx) {
    for (int half = 0; half < 2; ++half) {
        const size_t r0 = (size_t)half * (MTOK / 2);
        pg8::Gemm g{A + r0 * K, Bt, MTOK / 2, DM, K}; pg8::StaticOrder S; S.init(MTOK / 2, DM, G, bx);
        pg8::PanelStats st{(unsigned*)(ws + WS_XCH + (size_t)(gid * 2 + half) * SZ_XCH), (unsigned*)(ws + WS_CNT + (size_t)(gid * 2 + half) * 64 * 256), 1e-5f};
        pg8::EpiLnAff E{xb + r0 * DM, xf ? xf + r0 * DM : nullptr, xb + r0 * DM, gam, bet, alpha, beta, st};
        pg8::gemm_phase(lds, g, S, E);
    }
}

__global__ void __launch_bounds__(512, 2) hymba_fwd(Params p) {
    extern __shared__ __attribute__((aligned(16))) unsigned char shm[];
    LAS unsigned char* lds = (LAS unsigned char*)shm;
    cg::grid_group grid = cg::this_grid();
    unsigned char* ws = p.ws;
    const int G = gridDim.x, bx = blockIdx.x;
    bf16_t* xb = (bf16_t*)(ws + WS_XB); bf16_t* Hb = (bf16_t*)(ws + WS_H); bf16_t* proj = (bf16_t*)(ws + WS_PROJ); bf16_t* vtb = (bf16_t*)(ws + WS_VTB);
    bf16_t* concat = (bf16_t*)(ws + WS_CONCAT); bf16_t* kcmp = (bf16_t*)(ws + WS_KCMP); bf16_t* vcmpT = (bf16_t*)(ws + WS_VCMPT);
    float* xf = p.out;

    if (threadIdx.x < 4) ((LAS unsigned*)(lds + LDS_BYTES - 16))[threadIdx.x] = 0u;
    __syncthreads();
    const XcdBarrier xbar = xcd_barrier_post((unsigned*)(ws + WS_BAR), (volatile LAS unsigned*)(lds + LDS_BYTES - 16));
    p0_phase(p, lds);
    grid.sync();

    for (int l = 0; l < 2; ++l) {
        for (int f = 0; f < 2; ++f) {
            if (f == 1) {
                { pg8::Gemm g{xb, (const bf16_t*)(ws + WS_WIN + (size_t)l * SZ_WIN), MTOK, NPROJ, DM}; pg8::StaticOrder S; S.init(MTOK, NPROJ, G, bx);
                  pg8::EpiBf16 E{proj, NPROJ}; pg8::gemm_phase<pg8::EpiBf16, pg8::StaticOrder, true>(lds, g, S, E); }
                { pg8::Gemm g{(const bf16_t*)(ws + WS_WVT + (size_t)l * SZ_WVT), xb, NVT, MTOK, DM}; pg8::StaticOrder S; S.init(NVT, MTOK, G, bx);
                  pg8::EpiBf16 E{vtb, MTOK}; pg8::gemm_phase<pg8::EpiBf16, pg8::StaticOrder, true>(lds, g, S, E); }
                xcd_barrier(xbar);
                for (int it = bx; it < 256; it += G) compress_item(lds, it, proj, ws, l, kcmp, vcmpT);
                for (int it = bx; it < 512; it += G) pool_item(lds, it, proj, p.in[I_POOLW] + (size_t)l * 4 * 64 * 64, p.in[I_POOLS] + (size_t)l * 256, concat);
                xcd_barrier(xbar);
                for (int r = 0; r * G < 1024; ++r) { const int k = (r & 1) ? ((r + 1) * G - 1 - bx) : (r * G + bx); if (k >= 1024) continue;
                    const int c = 255 - (k >> 2), bg = k & 3; attn_item(lds, bg >> 1, bg & 1, c, proj, vtb, kcmp, vcmpT, p.in[I_BGATE] + (size_t)l * 24, concat); }
                xcd_barrier(xbar);
                gemm_ln(lds, ws, l * 3 + 1, concat, DM, (const bf16_t*)(ws + WS_WOUT + (size_t)l * SZ_WOUT), nullptr, xb, p.in[I_LN2G] + (size_t)l * DM, p.in[I_LN2B] + (size_t)l * DM, ALPHA, 1.0f, G, bx);
                xcd_barrier(xbar);
            }
            { pg8::Gemm g{xb, (const bf16_t*)(ws + WS_WGU + (size_t)(l * 2 + f) * SZ_WGU), MTOK, 2 * DFF, DM}; pg8::StaticOrder S; S.init(MTOK, 2 * DFF, G, bx);
              pg8::EpiSwiglu E{Hb, DFF}; pg8::gemm_phase<pg8::EpiSwiglu, pg8::StaticOrder, true>(lds, g, S, E); }
            xcd_barrier(xbar);
            gemm_ln(lds, ws, l * 3 + (f ? 2 : 0), Hb, DFF, (const bf16_t*)(ws + WS_WDN + (size_t)(l * 2 + f) * SZ_WDN), (l == 1 && f == 1) ? xf : nullptr, xb,
                    p.in[f ? I_LN3G : I_LN1G] + (size_t)l * DM, p.in[f ? I_LN3B : I_LN1B] + (size_t)l * DM, ALPHA, 0.5f, G, bx);
            xcd_barrier(xbar);
        }
    }
}

extern "C" void kernel_launch(void* const* d_in, const int* in_sizes, int n_in, void* d_out, int out_size, void* d_ws, size_t ws_size, hipStream_t stream) {
    static int grid_blocks = 0;
    if (!grid_blocks) {
        if (n_in != 24 || ws_size < WS_END2) { fprintf(stderr, "kernel_launch: unexpected n_in %d / ws %zu (need %zu)\n", n_in, ws_size, (size_t)WS_END2); grid_blocks = -1; return; }
        int dev = 0, cus = 0, per_cu = 0;
        hipGetDevice(&dev);
        hipDeviceGetAttribute(&cus, hipDeviceAttributeMultiprocessorCount, dev);
        if (hipFuncSetAttribute((const void*)hymba_fwd, hipFuncAttributeMaxDynamicSharedMemorySize, LDS_BYTES) != hipSuccess) { fprintf(stderr, "kernel_launch: hipFuncSetAttribute failed\n"); grid_blocks = -1; return; }
        hipOccupancyMaxActiveBlocksPerMultiprocessor(&per_cu, (const void*)hymba_fwd, 512, LDS_BYTES);
        if (per_cu < 1) per_cu = 1;
        if (cus < 256 || per_cu < 1) fprintf(stderr, "kernel_launch: note: %d CUs, occupancy query %d; this kernel is built for 256 co-resident workgroups (one per CU)\n", cus, per_cu);
        grid_blocks = 256;
        (void)hipGetLastError();
    }
    if (grid_blocks < 0) return;
    if (hipMemsetAsync((unsigned char*)d_ws + WS_CNT, 0, (size_t)12 * 64 * 256 + 16384, stream) != hipSuccess) { fprintf(stderr, "kernel_launch: hipMemsetAsync failed\n"); return; }
    Params p{};
    for (int i = 0; i < 24; ++i) p.in[i] = (const float*)d_in[i];
    p.out = (float*)d_out; p.ws = (unsigned char*)d_ws;
    void* args[] = {&p};
    hipError_t e = hipLaunchCooperativeKernel((const void*)hymba_fwd, dim3(grid_blocks), dim3(512), args, LDS_BYTES, stream);
    if (e != hipSuccess) fprintf(stderr, "cooperative launch failed: %s (grid %d)\n", hipGetErrorString(e), grid_blocks);
}
```
